# Optimizing an MI355X kernel written in HIP

```python
import jax, jax.numpy as jnp
from jax import lax
import numpy as np

D_MODEL = 2048
BATCH = 2
SEQ = 16384
DEPTH = 1

CHUNK = 64
PE_DIM = 256
HG_DK = 128
HG_DV = 128
HG_HEADS = D_MODEL // HG_DK
HG_KW = HG_HEADS * HG_DK
HG_VW = HG_HEADS * HG_DV
SB_DH = 128
SB_HEADS = 8
SB_W = SB_HEADS * SB_DH
Q_BLOCK = 128
LN_EPS = 1e-5
DN_ALPHA = (2 * DEPTH) ** 0.25
DN_BETA = (8 * DEPTH) ** -0.25
IN_SPLITS = (HG_KW, HG_KW, HG_VW, HG_VW, SB_W, SB_W, SB_W, SB_W)
IN_COLS = int(sum(IN_SPLITS))
IN_OFFSETS = tuple(int(o) for o in np.cumsum(IN_SPLITS)[:-1])

kernel_name = "hgrn2_stickbreak_gated_hybrid"


def layer_norm(x, g, b):
    xf = x.astype(jnp.float32)
    mu = jnp.mean(xf, axis=-1, keepdims=True)
    var = jnp.mean(jnp.square(xf - mu), axis=-1, keepdims=True)
    return ((xf - mu) * lax.rsqrt(var + LN_EPS) * g + b).astype(x.dtype)


def group_rms_norm(y, g):
    yf = y.astype(jnp.float32)
    yf = yf * lax.rsqrt(jnp.mean(jnp.square(yf), axis=-1, keepdims=True) + LN_EPS)
    Bn, T, H, d = y.shape
    return yf.reshape(Bn, T, H * d) * g


def hgrn2(q, f_logit, i_in, lb):
    f32 = jnp.float32
    Bn, T, H, DK = q.shape
    DV = i_in.shape[-1]
    nc = T // CHUNK
    lbh = lb.reshape(H, DK)
    f = lbh + (1.0 - lbh) * jax.nn.sigmoid(f_logit.astype(f32))
    logf = jnp.log(f)
    k = 1.0 - f

    def chunks(a):
        return a.reshape(Bn, nc, CHUNK, H, a.shape[-1]).transpose(1, 0, 3, 2, 4)

    qc = chunks(q.astype(f32))
    kc = chunks(k)
    vc = chunks(i_in.astype(f32))
    bc = jnp.cumsum(chunks(logf), axis=3)
    b_last = bc[:, :, :, -1:, :]
    q_dec = qc * jnp.exp(bc)
    k_inv = kc * jnp.exp(-bc)
    k_end = kc * jnp.exp(b_last - bc)
    decay = jnp.exp(b_last[:, :, :, 0, :])
    causal = jnp.tril(jnp.ones((CHUNK, CHUNK), dtype=bool))

    def step(S, xs):
        qd, ki, ke, v, dec = xs
        a = jnp.where(causal, jnp.einsum('bhtk,bhsk->bhts', qd, ki), 0.0)
        o = jnp.einsum('bhts,bhsv->bhtv', a, v) + jnp.einsum('bhtk,bhkv->bhtv', qd, S)
        S = dec[..., None] * S + jnp.einsum('bhsk,bhsv->bhkv', ke, v)
        return S, o

    S0 = jnp.zeros((Bn, H, DK, DV), f32)
    _, o = lax.scan(step, S0, (q_dec, k_inv, k_end, vc, decay))
    return o.transpose(1, 0, 3, 2, 4).reshape(Bn, T, H, DV)


def stick_breaking(q, k, v):
    f32 = jnp.float32
    Bn, T, H, D = q.shape
    scale = D ** -0.5
    nb = T // Q_BLOCK

    def blocks(a):
        return a.reshape(Bn, nb, Q_BLOCK, H, D).transpose(1, 0, 3, 2, 4)

    qb, kb, vb = blocks(q), blocks(k), blocks(v)
    idx = jnp.arange(Q_BLOCK)
    strict = idx[None, :] < idx[:, None]
    later = (idx[:, None] > idx[None, :]).astype(f32)
    acc = jnp.zeros((nb, Bn, H, Q_BLOCK, D), f32)
    R = jnp.zeros((nb, Bn, H, Q_BLOCK), f32)
    for d in range(nb):
        n = nb - d
        z = jnp.einsum('nbhqd,nbhkd->nbhqk', qb[d:], kb[:n]).astype(f32) * scale
        l = jax.nn.log_sigmoid(-z)
        if d == 0:
            l = jnp.where(strict, l, 0.0)
        suffix = jnp.einsum('nbhqj,js->nbhqs', l, later)
        A = jnp.exp(jax.nn.log_sigmoid(z) + suffix + R[d:, ..., None])
        if d == 0:
            A = jnp.where(strict, A, 0.0)
        acc = acc.at[d:].add(jnp.einsum('nbhqk,nbhkd->nbhqd', A.astype(vb.dtype), vb[:n]).astype(f32))
        R = R.at[d:].add(jnp.sum(l, axis=-1))
    return acc.transpose(1, 0, 3, 2, 4).reshape(Bn, T, H, D).astype(q.dtype)


def setup_inputs(seed: int = 0) -> dict:
    key = jax.random.key(seed)
    ks = jax.random.split(key, 18)
    f32 = jnp.float32

    def nrm(k, shape, s):
        return jax.random.normal(k, shape, f32) * s

    return {
        "x": nrm(ks[0], (BATCH, SEQ, D_MODEL), 1.0),
        "p": nrm(ks[1], (DEPTH, BATCH, SEQ, PE_DIM), 1.0),
        "ln_in_g": 1.0 + nrm(ks[2], (D_MODEL,), 0.02),
        "ln_in_b": nrm(ks[3], (D_MODEL,), 0.02),
        "w_in": nrm(ks[4], (DEPTH, D_MODEL, IN_COLS), D_MODEL ** -0.5),
        "hg_lb_logits": nrm(ks[5], (DEPTH + 1, HG_KW), 0.1),
        "hg_norm_g": 1.0 + nrm(ks[6], (DEPTH, HG_VW), 0.02),
        "w_merge": nrm(ks[7], (DEPTH, D_MODEL, 2 * D_MODEL), D_MODEL ** -0.5),
        "b_merge": nrm(ks[8], (DEPTH, 2 * D_MODEL), 0.02),
        "w_br_hg": nrm(ks[9], (DEPTH, HG_VW, D_MODEL), HG_VW ** -0.5),
        "w_br_sb": nrm(ks[10], (DEPTH, SB_W, D_MODEL), SB_W ** -0.5),
        "w_out": nrm(ks[11], (DEPTH, D_MODEL, D_MODEL), DN_BETA * D_MODEL ** -0.5),
        "w_pe": nrm(ks[12], (DEPTH, PE_DIM, D_MODEL), DN_BETA * PE_DIM ** -0.5),
        "w_pg": nrm(ks[13], (DEPTH, D_MODEL, D_MODEL), D_MODEL ** -0.5),
        "b_pg": nrm(ks[14], (DEPTH, D_MODEL), 0.02),
        "ln_g": 1.0 + nrm(ks[15], (DEPTH, D_MODEL), 0.02),
        "ln_b": nrm(ks[16], (DEPTH, D_MODEL), 0.02),
    }


def reference(x, p, ln_in_g, ln_in_b, w_in, hg_lb_logits, hg_norm_g, w_merge, b_merge,
              w_br_hg, w_br_sb, w_out, w_pe, w_pg, b_pg, ln_g, ln_b):
    Bn, T, _ = x.shape
    h = layer_norm(x, ln_in_g, ln_in_b)
    lb_all = jnp.cumsum(jax.nn.softmax(hg_lb_logits.astype(jnp.float32), axis=0), axis=0)
    for i in range(DEPTH):
        proj = h @ w_in[i]
        hq, hf, hi, hg, sq, sk, sv, sg = jnp.split(proj, IN_OFFSETS, axis=-1)
        oa = hgrn2(hq.reshape(Bn, T, HG_HEADS, HG_DK), hf.reshape(Bn, T, HG_HEADS, HG_DK),
                   hi.reshape(Bn, T, HG_HEADS, HG_DV), lb_all[i])
        ya = (group_rms_norm(oa, hg_norm_g[i]) * jax.nn.silu(hg.astype(jnp.float32))).astype(h.dtype)
        ob = stick_breaking(sq.reshape(Bn, T, SB_HEADS, SB_DH), sk.reshape(Bn, T, SB_HEADS, SB_DH),
                            sv.reshape(Bn, T, SB_HEADS, SB_DH)).reshape(Bn, T, SB_W)
        yb = ob * jax.nn.silu(sg)
        gates = jax.nn.sigmoid(h @ w_merge[i] + b_merge[i])
        ga, gb = jnp.split(gates, 2, axis=-1)
        m = ga * (ya @ w_br_hg[i]) + gb * (yb @ w_br_sb[i])
        r = DN_ALPHA * h + m @ w_out[i]
        r = r + jax.nn.sigmoid(r @ w_pg[i] + b_pg[i]) * (p[i] @ w_pe[i])
        h = layer_norm(r, ln_g[i], ln_b[i])
    return h
```

```cpp
#include <hip/hip_runtime.h>
#include <hip/hip_cooperative_groups.h>
#include <cstdio>
namespace cg = cooperative_groups;

#ifndef MK_MULTI
#define MK_MULTI 0
#endif

#define LAS __attribute__((address_space(3)))
typedef unsigned short bf16_t;
typedef short bf16x8 __attribute__((ext_vector_type(8)));
typedef float f32x2 __attribute__((ext_vector_type(2)));
typedef float f32x4 __attribute__((ext_vector_type(4)));
typedef float f32x16 __attribute__((ext_vector_type(16)));
typedef unsigned u32x4 __attribute__((ext_vector_type(4)));
typedef unsigned u32x2 __attribute__((ext_vector_type(2)));
typedef __bf16 bf2_t __attribute__((ext_vector_type(2)));

constexpr int TOK = 32768, DM = 2048, SEQ_T = 16384;
constexpr float LN_EPS = 1e-5f;
constexpr float DN_ALPHA = 1.189207115002721f;

constexpr size_t WS_WTMAIN = 0;
constexpr size_t WS_WTVT   = WS_WTMAIN + (size_t)9216 * 2048 * 2;
constexpr size_t WS_WMT    = WS_WTVT + (size_t)3072 * 2048 * 2;
constexpr size_t WS_WAT    = WS_WMT + (size_t)4096 * 2048 * 2;
constexpr size_t WS_WBT    = WS_WAT + (size_t)2048 * 2048 * 2;
constexpr size_t WS_WOT    = WS_WBT + (size_t)2048 * 1024 * 2;
constexpr size_t WS_WPGT   = WS_WOT + (size_t)2048 * 2048 * 2;
constexpr size_t WS_WPET   = WS_WPGT + (size_t)2048 * 2048 * 2;
constexpr size_t WS_H      = WS_WPET + (size_t)2048 * 256 * 2;
constexpr size_t WS_QD     = WS_H + (size_t)TOK * 2048 * 2;
constexpr size_t WS_HG     = WS_QD + (size_t)TOK * 2048 * 2;
constexpr size_t WS_VT     = WS_HG + (size_t)TOK * 2048 * 2;
constexpr size_t WS_SQ     = WS_VT + (size_t)3072 * TOK * 2;
constexpr size_t WS_SK     = WS_SQ + (size_t)TOK * 1024 * 2;
constexpr size_t WS_SG     = WS_SK + (size_t)TOK * 1024 * 2;
constexpr size_t WS_PB     = WS_SG + (size_t)TOK * 1024 * 2;
constexpr size_t WS_DEC    = WS_PB + (size_t)TOK * 256 * 2;
constexpr size_t WS_STATS  = WS_DEC + (size_t)512 * 2048 * 4;
constexpr size_t WS_YB     = WS_SG;
constexpr size_t WS_GA     = WS_STATS + (size_t)TOK * 2 * 4;
constexpr size_t WS_GB     = WS_GA + (size_t)TOK * 2048;
constexpr size_t WS_BAR    = WS_GB + (size_t)TOK * 2048;
constexpr size_t WS_END    = WS_BAR + 16384;

struct Params {
    const float *x, *p, *ln_in_g, *ln_in_b, *w_in, *lb_logits, *hg_norm_g, *w_merge, *b_merge, *w_br_hg, *w_br_sb, *w_out, *w_pe, *w_pg, *b_pg, *ln_g, *ln_b;
    float* out; unsigned char* ws;
    int ph_lo, ph_hi;
};

__device__ __forceinline__ unsigned pk2(float lo, float hi) { f32x2 v = {lo, hi}; bf2_t b = __builtin_convertvector(v, bf2_t); return __builtin_bit_cast(unsigned, b); }
__device__ __forceinline__ float bf_lo(unsigned u) { return __uint_as_float(u << 16); }
__device__ __forceinline__ float bf_hi(unsigned u) { return __uint_as_float(u & 0xffff0000u); }
__device__ __forceinline__ float fast_exp(float x) { return __builtin_amdgcn_exp2f(x * 1.4426950408889634f); }
__device__ __forceinline__ float fast_log(float x) { return __builtin_amdgcn_logf(x) * 0.6931471805599453f; }
__device__ __forceinline__ float fast_rcp(float x) { return __builtin_amdgcn_rcpf(x); }
__device__ __forceinline__ float sigmoidf_(float x) { return fast_rcp(1.f + fast_exp(-x)); }
__device__ __forceinline__ float lane_read(float v, int src_lane) { return __int_as_float(__builtin_amdgcn_ds_bpermute(src_lane << 2, __float_as_int(v))); }
__device__ __forceinline__ float wave_sum(float v, int lane) {
#pragma unroll
    for (int o = 1; o < 64; o <<= 1) v += lane_read(v, lane ^ o);
    return v;
}
__device__ __forceinline__ int tid_opaque() { int t = threadIdx.x; asm volatile("" : "+v"(t)); return t; }
#define MFMA32(a, b, c) __builtin_amdgcn_mfma_f32_32x32x16_bf16((a), (b), (c), 0, 0, 0)
__device__ __forceinline__ int crow(int reg, int h) { return (reg & 3) + 8 * (reg >> 2) + 4 * h; }

namespace pg8 {
constexpr int BM = 256, BK = 64, HALF = 128, HTB = HALF * BK * 2, STAGE_BYTES = 8 * HTB, NXCD = 8, WGM = 8;
__device__ __forceinline__ int lds_byte(int r, int c) { const int st = (r >> 4) * 2 + (c >> 5), rr = r & 15, cc = c & 31, ob = rr * 64 + cc * 2; return st * 1024 + (ob ^ (((ob >> 9) & 1) << 5)); }
__device__ __forceinline__ void stage_rc(int b, int& R, int& C) { const int st = b / 1024, sb = b % 1024, swz = sb ^ (((sb >> 9) & 1) << 5); R = (st >> 1) * 16 + swz / 64; C = (st & 1) * 32 + (swz % 64) / 2; }
__device__ __forceinline__ int perm32(int rho) { const int n = rho >> 4, i = rho & 15; return 8 * (i >> 2) + 4 * n + (i & 3); }
struct Unit { int pm, pn; };
struct Gemm { const bf16_t* A; const bf16_t* Bt; int M, N, K; };
struct StaticOrder {
    int nM, nN, nwg, G, c;
    __device__ void init(int M, int N, int G_, int c_) { nM = M / BM; nN = N / BM; nwg = nM * nN; G = G_; c = c_; }
    __device__ bool next(int i, Unit& u) const {
        const long L = (long)i * G + c; if (L >= nwg) return false;
        int wgid = (int)L; { const int q = nwg / NXCD, r = nwg % NXCD, xcd = wgid % NXCD, off = wgid / NXCD; wgid = (xcd < r ? xcd * (q + 1) : r * (q + 1) + (xcd - r) * q) + off; }
        const int nig = WGM * nN, gid = wgid / nig, fm = gid * WGM, gsz = (nM - fm) < WGM ? (nM - fm) : WGM;
        u.pm = fm + ((wgid % nig) % gsz); u.pn = (wgid % nig) / gsz; return true;
    }
};
template <class Epi>
__device__ __forceinline__ void gemm_phase(LAS unsigned char* lds, const Gemm g, const StaticOrder& S, const Epi& E) {
    const int K = g.K, nt = K / BK;
    int wr, wc, fr, fq, aoff, boff; unsigned voffA[2], voffB[2], ldsw;
#define PG8_SETUP() do { const int tid = tid_opaque(), wid = __builtin_amdgcn_readfirstlane(tid >> 6), lane = tid & 63; wr = wid >> 2; wc = wid & 3; fr = lane & 15; fq = lane >> 4; \
        _Pragma("unroll") for (int i = 0; i < 2; ++i) { int R, C; stage_rc(tid * 16 + i * 8192, R, C); const int Rb = (R & ~31) + perm32(R & 31); \
            voffA[i] = (unsigned)(R * K + C) * 2u; voffB[i] = (unsigned)(Rb * K + C) * 2u; } \
        ldsw = (unsigned)wid * 1024u; aoff = lds_byte(wr * 64 + fr, fq * 8); boff = lds_byte(wc * 32 + fr, fq * 8); } while (0)
    PG8_SETUP();
    const size_t kstep = (size_t)(BK * 2);
    const size_t hstep = (size_t)HALF * K * 2;
    const size_t tstep = 2 * hstep;
#define PG8_SA(b, h) (((b) * 2 + (h)) * HTB)
#define PG8_SB(b, h) ((4 + (b) * 2 + (h)) * HTB)
#define PG8_STAGE(bufoff, gbase, voff) do { _Pragma("unroll") for (int _i = 0; _i < 2; ++_i) \
        __builtin_amdgcn_global_load_lds((const unsigned*)((const char*)(gbase) + (voff)[_i]), (LAS unsigned*)(lds + (bufoff) + ldsw + _i * 8192), 16, 0, 0); } while (0)
#define PG8_LDA(dst, b, h) do { _Pragma("unroll") for (int m = 0; m < 4; ++m) _Pragma("unroll") for (int k = 0; k < 2; ++k) dst[m][k] = *(const LAS bf16x8*)(lds + PG8_SA(b, h) + aoff + m * 2048 + k * 1024); } while (0)
#define PG8_LDB(dst, b, h) do { _Pragma("unroll") for (int n = 0; n < 2; ++n) _Pragma("unroll") for (int k = 0; k < 2; ++k) dst[n][k] = *(const LAS bf16x8*)(lds + PG8_SB(b, h) + boff + n * 2048 + k * 1024); } while (0)
#define PG8_MMA(ai, bj, At, Bt) do { __builtin_amdgcn_s_setprio(1); _Pragma("unroll") for (int m = 0; m < 4; ++m) _Pragma("unroll") for (int n = 0; n < 2; ++n) _Pragma("unroll") for (int k = 0; k < 2; ++k) \
        acc[ai][bj][m][n] = __builtin_amdgcn_mfma_f32_16x16x32_bf16(Bt[n][k], At[m][k], acc[ai][bj][m][n], 0, 0, 0); __builtin_amdgcn_s_setprio(0); } while (0)
#define PG8_WAIT_V(n) asm volatile("s_waitcnt vmcnt(" #n ")" ::: "memory")
#define PG8_WAIT_L(n) asm volatile("s_waitcnt lgkmcnt(" #n ")" ::: "memory")
#define PG8_BAR __builtin_amdgcn_s_barrier()
#define PG8_SCHED __builtin_amdgcn_sched_barrier(0)
    Unit cur, nxt; int ui = 0;
    if (!S.next(0, cur)) return;
    f32x4 acc[2][2][4][2];
#pragma unroll
    for (int a = 0; a < 2; ++a)
#pragma unroll
        for (int b = 0; b < 2; ++b)
#pragma unroll
            for (int m = 0; m < 4; ++m)
#pragma unroll
                for (int n = 0; n < 2; ++n) acc[a][b][m][n] = (f32x4){0.f, 0.f, 0.f, 0.f};
    bf16x8 At[4][2], B0[2][2], B1[2][2];
    const char* cA = (const char*)g.A + (size_t)cur.pm * tstep; const char* cB = (const char*)g.Bt + (size_t)cur.pn * tstep;
    PG8_WAIT_V(0);
    PG8_STAGE(PG8_SB(0, 0), cB, voffB); PG8_STAGE(PG8_SA(0, 0), cA, voffA); PG8_STAGE(PG8_SB(0, 1), cB + hstep, voffB); PG8_STAGE(PG8_SA(0, 1), cA + hstep, voffA);
    if (wr == 1) PG8_BAR;
    PG8_WAIT_V(4); PG8_BAR;
    PG8_STAGE(PG8_SB(1, 0), cB + kstep, voffB); PG8_STAGE(PG8_SA(1, 0), cA + kstep, voffA); PG8_STAGE(PG8_SB(1, 1), cB + hstep + kstep, voffB);
    PG8_WAIT_V(6); PG8_BAR;
    for (;;) {
        const bool has_next = S.next(ui + 1, nxt);
        const char* nA = has_next ? (const char*)g.A + (size_t)nxt.pm * tstep : cA; const char* nB = has_next ? (const char*)g.Bt + (size_t)nxt.pn * tstep : cB;
        for (int t = 0; t < nt; t += 2) {
            const bool last = (t == nt - 2);
            const char* a1 = cA + (size_t)(t + 1) * kstep;
            const char* a2 = last ? nA : cA + (size_t)(t + 2) * kstep; const char* b2 = last ? nB : cB + (size_t)(t + 2) * kstep;
            const char* a3 = a2 + kstep; const char* b3 = b2 + kstep;
            PG8_LDB(B0, 0, 0); PG8_SCHED; PG8_LDA(At, 0, 0); PG8_STAGE(PG8_SA(1, 1), a1 + hstep, voffA);
            PG8_WAIT_L(8); PG8_BAR; PG8_WAIT_L(0); PG8_MMA(0, 0, At, B0); PG8_BAR; PG8_SCHED;
            PG8_LDB(B1, 0, 1); PG8_STAGE(PG8_SB(0, 0), b2, voffB);
            PG8_BAR; PG8_WAIT_L(0); PG8_MMA(0, 1, At, B1); PG8_BAR;
            PG8_LDA(At, 0, 1); PG8_STAGE(PG8_SA(0, 0), a2, voffA);
            PG8_BAR; PG8_WAIT_L(0); PG8_MMA(1, 0, At, B0); PG8_BAR; PG8_SCHED;
            PG8_STAGE(PG8_SB(0, 1), b2 + hstep, voffB);
            PG8_WAIT_V(6); PG8_BAR; PG8_MMA(1, 1, At, B1); PG8_BAR;
            PG8_LDB(B0, 1, 0); PG8_SCHED; PG8_LDA(At, 1, 0); PG8_STAGE(PG8_SA(0, 1), a2 + hstep, voffA);
            PG8_WAIT_L(8); PG8_BAR; PG8_WAIT_L(0); PG8_MMA(0, 0, At, B0); PG8_BAR; PG8_SCHED;
            PG8_LDB(B1, 1, 1); PG8_STAGE(PG8_SB(1, 0), b3, voffB);
            PG8_BAR; PG8_WAIT_L(0); PG8_MMA(0, 1, At, B1); PG8_BAR;
            PG8_LDA(At, 1, 1); PG8_STAGE(PG8_SA(1, 0), a3, voffA);
            PG8_BAR; PG8_WAIT_L(0); PG8_MMA(1, 0, At, B0); PG8_BAR; PG8_SCHED;
            PG8_STAGE(PG8_SB(1, 1), b3 + hstep, voffB);
            PG8_WAIT_V(6); PG8_BAR; PG8_MMA(1, 1, At, B1); PG8_BAR;
        }
        E(acc, cur, wr, wc, fr, fq);
        PG8_WAIT_V(0);
        if (!has_next) break;
#pragma unroll
        for (int a = 0; a < 2; ++a)
#pragma unroll
            for (int b = 0; b < 2; ++b)
#pragma unroll
                for (int m = 0; m < 4; ++m)
#pragma unroll
                    for (int n = 0; n < 2; ++n) acc[a][b][m][n] = (f32x4){0.f, 0.f, 0.f, 0.f};
        cur = nxt; cA = nA; cB = nB; ++ui;
        PG8_SETUP();
    }
    PG8_WAIT_V(0);
    if (wr == 0) PG8_BAR;
    PG8_BAR;
#undef PG8_SETUP
#undef PG8_SA
#undef PG8_SB
#undef PG8_STAGE
#undef PG8_LDA
#undef PG8_LDB
#undef PG8_MMA
#undef PG8_WAIT_V
#undef PG8_WAIT_L
#undef PG8_BAR
#undef PG8_SCHED
}
}
using pg8::Unit;
typedef const f32x4 (&AccRef)[2][2][4][2];

__device__ __forceinline__ u32x4 pack8(f32x4 a, f32x4 b) { u32x4 w; w.x = pk2(a[0], a[1]); w.y = pk2(a[2], a[3]); w.z = pk2(b[0], b[1]); w.w = pk2(b[2], b[3]); return w; }
__device__ __forceinline__ void unpack8(u32x4 w, f32x4& a, f32x4& b) { a[0] = bf_lo(w.x); a[1] = bf_hi(w.x); a[2] = bf_lo(w.y); a[3] = bf_hi(w.y); b[0] = bf_lo(w.z); b[1] = bf_hi(w.z); b[2] = bf_lo(w.w); b[3] = bf_hi(w.w); }

__device__ __forceinline__ void store_plain(AccRef acc, bf16_t* dst, size_t ld, int rowt, int colt, int wr, int wc, int fr, int fq) {
    const int row0 = rowt * 256 + wr * 64 + fr, col0 = colt * 256 + wc * 32 + 8 * fq;
#pragma unroll
    for (int ai = 0; ai < 2; ++ai)
#pragma unroll
        for (int m = 0; m < 4; ++m) { bf16_t* rowp = dst + (size_t)(row0 + ai * 128 + m * 16) * ld + col0;
#pragma unroll
            for (int bj = 0; bj < 2; ++bj) *(u32x4*)(rowp + bj * 128) = pack8(acc[ai][bj][m][0], acc[ai][bj][m][1]); __builtin_amdgcn_sched_barrier(0); }
}

template <int CTRL> __device__ __forceinline__ float dpp_mov0(float x) { return __int_as_float(__builtin_amdgcn_update_dpp(0, __float_as_int(x), CTRL, 0xf, 0xf, true)); }
__device__ __forceinline__ float scan16(float x) { x += dpp_mov0<0x111>(x); x += dpp_mov0<0x112>(x); x += dpp_mov0<0x114>(x); x += dpp_mov0<0x118>(x); return x; }

struct EpiProj {
    static constexpr bool PERM = true;
    bf16_t *QD, *KI, *KET, *HG, *SQ, *SK, *SG; float* DEC; const float* lbl;
    __device__ __forceinline__ void operator()(AccRef acc, const Unit& u, int wr, int wc, int fr, int fq) const {
        if (u.pn >= 16) {
            if (u.pn < 24) store_plain(acc, HG, 2048, u.pm, u.pn - 16, wr, wc, fr, fq);
            else if (u.pn < 28) store_plain(acc, SQ, 1024, u.pm, u.pn - 24, wr, wc, fr, fq);
            else if (u.pn < 32) store_plain(acc, SK, 1024, u.pm, u.pn - 28, wr, wc, fr, fq);
            else store_plain(acc, SG, 1024, u.pm, u.pn - 32, wr, wc, fr, fq);
            return;
        }
        const int head = u.pn, kk0 = wc * 32 + 8 * fq, hc0 = head * 128 + kk0;
        const int lane = fr + 16 * fq;
        float lbreg; { const int cc = head * 128 + wc * 32 + (lane & 31); const float l0 = lbl[cc], l1 = lbl[2048 + cc]; lbreg = fast_rcp(1.f + fast_exp(l1 - l0)); }
#pragma unroll
        for (int ai = 0; ai < 2; ++ai) {
            const int rowb = u.pm * 256 + ai * 128 + wr * 64, row0 = rowb + fr, chunk = rowb >> 6;
            unsigned qdp[4][4], kip[4][4];
#pragma unroll
            for (int n = 0; n < 2; ++n) {
#pragma unroll
                for (int jp = 0; jp < 2; ++jp) {
                    float qd2[4], ki2[4], dec2;
#pragma unroll
                    for (int e = 0; e < 2; ++e) {
                        const int j = 2 * jp + e, c = 4 * n + j;
                        const float lb = lane_read(lbreg, 8 * fq + c);
                        float lf[4], kv[4];
#pragma unroll
                        for (int m = 0; m < 4; ++m) { const float xx = acc[ai][1][m][n][j]; const float f = lb + (1.f - lb) * sigmoidf_(xx); kv[m] = 1.f - f; lf[m] = scan16(fast_log(f)); }
                        const int src = lane | 15;
                        const float t0 = lane_read(lf[0], src), t1 = lane_read(lf[1], src), t2 = lane_read(lf[2], src), t3 = lane_read(lf[3], src);
                        float bc[4]; bc[0] = lf[0]; bc[1] = lf[1] + t0; bc[2] = lf[2] + (t0 + t1); bc[3] = lf[3] + (t0 + t1 + t2);
                        const float dec = fast_exp(t0 + t1 + t2 + t3);
#pragma unroll
                        for (int m = 0; m < 4; ++m) { const float ee = fast_exp(bc[m]); const float qd = acc[ai][0][m][n][j] * ee; const float ki = kv[m] * fast_rcp(ee);
                            const float ke = ki * dec; KET[(unsigned)((chunk * 2048 + hc0 + c) * 64 + fr + 16 * m)] = (bf16_t)(pk2(ke, 0.f) & 0xffffu);
                            if (e == 0) { qd2[m] = qd; ki2[m] = ki; }
                            else { qdp[m][2 * n + jp] = pk2(qd2[m], qd); kip[m][2 * n + jp] = pk2(ki2[m], ki); } }
                        if (e == 0) dec2 = dec;
                        else if (fr == 0) { float* dp = DEC + (unsigned)(chunk * 2048 + hc0 + 4 * n + 2 * jp); *(f32x2*)dp = (f32x2){dec2, dec}; }
                        __builtin_amdgcn_sched_barrier(0);
                    }
                }
            }
#pragma unroll
            for (int m = 0; m < 4; ++m) { const unsigned o = (unsigned)((row0 + 16 * m) * 2048 + hc0);
                u32x4 qa; qa.x = qdp[m][0]; qa.y = qdp[m][1]; qa.z = qdp[m][2]; qa.w = qdp[m][3]; *(u32x4*)(QD + o) = qa;
                u32x4 kb_; kb_.x = kip[m][0]; kb_.y = kip[m][1]; kb_.z = kip[m][2]; kb_.w = kip[m][3]; *(u32x4*)(KI + o) = kb_; }
        }
    }
};
struct EpiPlain {
    static constexpr bool PERM = true;
    bf16_t* dst; int ld;
    __device__ __forceinline__ void operator()(AccRef acc, const Unit& u, int wr, int wc, int fr, int fq) const { store_plain(acc, dst, (size_t)ld, u.pm, u.pn, wr, wc, fr, fq); }
};
struct EpiVT {
    static constexpr bool PERM = true;
    bf16_t* dst;
    __device__ __forceinline__ void operator()(AccRef acc, const Unit& u, int wr, int wc, int fr, int fq) const {
        const int row0 = u.pm * 256 + wr * 64 + fr, col0 = u.pn * 256 + wc * 32 + 8 * fq;
#pragma unroll
        for (int ai = 0; ai < 2; ++ai)
#pragma unroll
            for (int m = 0; m < 4; ++m)
#pragma unroll
                for (int bj = 0; bj < 2; ++bj) { const int row = row0 + ai * 128 + m * 16, col = col0 + bj * 128;
                    *(u32x4*)(dst + ((size_t)((col >> 6) * 3072 + row) * 64 + (col & 63))) = pack8(acc[ai][bj][m][0], acc[ai][bj][m][1]); __builtin_amdgcn_sched_barrier(0); }
    }
};
__device__ __forceinline__ unsigned q8(float g) { return (unsigned)(g * 255.f + 0.5f); }
__device__ __forceinline__ u32x2 pack8u(f32x4 a, f32x4 b) { u32x2 w; w.x = q8(a[0]) | (q8(a[1]) << 8) | (q8(a[2]) << 16) | (q8(a[3]) << 24); w.y = q8(b[0]) | (q8(b[1]) << 8) | (q8(b[2]) << 16) | (q8(b[3]) << 24); return w; }
__device__ __forceinline__ void unpack8u(u32x2 w, f32x4& a, f32x4& b) { const float k = 1.f / 255.f;
    a[0] = (float)(w.x & 255u) * k; a[1] = (float)((w.x >> 8) & 255u) * k; a[2] = (float)((w.x >> 16) & 255u) * k; a[3] = (float)(w.x >> 24) * k;
    b[0] = (float)(w.y & 255u) * k; b[1] = (float)((w.y >> 8) & 255u) * k; b[2] = (float)((w.y >> 16) & 255u) * k; b[3] = (float)(w.y >> 24) * k; }
struct EpiGate {
    static constexpr bool PERM = true;
    unsigned char *ga, *gb; const float* bias;
    __device__ __forceinline__ void operator()(AccRef acc, const Unit& u, int wr, int wc, int fr, int fq) const {
        unsigned char* dst = u.pn < 8 ? ga : gb;
        const int row0 = u.pm * 256 + wr * 64 + fr, col0 = (u.pn & 7) * 256 + wc * 32 + 8 * fq, bcol0 = u.pn * 256 + wc * 32 + 8 * fq;
#pragma unroll
        for (int bj = 0; bj < 2; ++bj) { const f32x4 b0 = *(const f32x4*)(bias + bcol0 + bj * 128), b1 = *(const f32x4*)(bias + bcol0 + bj * 128 + 4);
#pragma unroll
            for (int ai = 0; ai < 2; ++ai)
#pragma unroll
                for (int m = 0; m < 4; ++m) { f32x4 v0 = acc[ai][bj][m][0] + b0, v1 = acc[ai][bj][m][1] + b1;
#pragma unroll
                    for (int j = 0; j < 4; ++j) { v0[j] = sigmoidf_(v0[j]); v1[j] = sigmoidf_(v1[j]); }
                    *(u32x2*)(dst + (size_t)(row0 + ai * 128 + m * 16) * 2048 + col0 + bj * 128) = pack8u(v0, v1); __builtin_amdgcn_sched_barrier(0); } }
    }
};
struct EpiMul {
    static constexpr bool PERM = true;
    bf16_t* m1; const unsigned char* G;
    __device__ __forceinline__ void operator()(AccRef acc, const Unit& u, int wr, int wc, int fr, int fq) const {
        const int row0 = u.pm * 256 + wr * 64 + fr, col0 = u.pn * 256 + wc * 32 + 8 * fq;
#pragma unroll
        for (int ai = 0; ai < 2; ++ai)
#pragma unroll
            for (int m = 0; m < 4; ++m)
#pragma unroll
                for (int bj = 0; bj < 2; ++bj) { const size_t o = (size_t)(row0 + ai * 128 + m * 16) * 2048 + col0 + bj * 128;
                    f32x4 g0, g1; unpack8u(*(const u32x2*)(G + o), g0, g1);
                    *(u32x4*)(m1 + o) = pack8(acc[ai][bj][m][0] * g0, acc[ai][bj][m][1] * g1); __builtin_amdgcn_sched_barrier(0); }
    }
};
struct EpiMulAdd {
    static constexpr bool PERM = true;
    bf16_t* mo; const bf16_t* m1; const unsigned char* G;
    __device__ __forceinline__ void operator()(AccRef acc, const Unit& u, int wr, int wc, int fr, int fq) const {
        const int row0 = u.pm * 256 + wr * 64 + fr, col0 = u.pn * 256 + wc * 32 + 8 * fq;
#pragma unroll
        for (int ai = 0; ai < 2; ++ai)
#pragma unroll
            for (int m = 0; m < 4; ++m)
#pragma unroll
                for (int bj = 0; bj < 2; ++bj) { const size_t o = (size_t)(row0 + ai * 128 + m * 16) * 2048 + col0 + bj * 128;
                    f32x4 g0, g1; unpack8u(*(const u32x2*)(G + o), g0, g1);
                    f32x4 a0, a1; unpack8(*(const u32x4*)(m1 + o), a0, a1);
                    *(u32x4*)(mo + o) = pack8(a0 + acc[ai][bj][m][0] * g0, a1 + acc[ai][bj][m][1] * g1); __builtin_amdgcn_sched_barrier(0); }
    }
};
struct EpiOut {
    static constexpr bool PERM = true;
    float* r; bf16_t* rb; const float *x, *stats, *g, *b;
    __device__ __forceinline__ void operator()(AccRef acc, const Unit& u, int wr, int wc, int fr, int fq) const {
        const int row0 = u.pm * 256 + wr * 64 + fr, col0 = u.pn * 256 + wc * 32 + 8 * fq;
#pragma unroll
        for (int bj = 0; bj < 2; ++bj) { const int c = col0 + bj * 128;
            const f32x4 g0 = *(const f32x4*)(g + c), g1 = *(const f32x4*)(g + c + 4), b0 = *(const f32x4*)(b + c), b1 = *(const f32x4*)(b + c + 4);
#pragma unroll
            for (int ai = 0; ai < 2; ++ai)
#pragma unroll
                for (int m = 0; m < 4; ++m) { const int row = row0 + ai * 128 + m * 16; const size_t o = (size_t)row * 2048 + c;
                    const float mean = stats[2 * row], rstd = stats[2 * row + 1];
                    const f32x4 x0 = *(const f32x4*)(x + o), x1 = *(const f32x4*)(x + o + 4);
                    const f32x4 r0 = ((x0 - mean) * rstd * g0 + b0) * DN_ALPHA + acc[ai][bj][m][0], r1 = ((x1 - mean) * rstd * g1 + b1) * DN_ALPHA + acc[ai][bj][m][1];
                    *(f32x4*)(r + o) = r0; *(f32x4*)(r + o + 4) = r1; *(u32x4*)(rb + o) = pack8(r0, r1); __builtin_amdgcn_sched_barrier(0); } }
    }
};
struct EpiFinal {
    static constexpr bool PERM = true;
    float* r; const bf16_t* pe; const float* bias;
    __device__ __forceinline__ void operator()(AccRef acc, const Unit& u, int wr, int wc, int fr, int fq) const {
        const int row0 = u.pm * 256 + wr * 64 + fr, col0 = u.pn * 256 + wc * 32 + 8 * fq;
#pragma unroll
        for (int bj = 0; bj < 2; ++bj) { const int c = col0 + bj * 128;
            const f32x4 b0 = *(const f32x4*)(bias + c), b1 = *(const f32x4*)(bias + c + 4);
#pragma unroll
            for (int ai = 0; ai < 2; ++ai)
#pragma unroll
                for (int m = 0; m < 4; ++m) { const size_t o = (size_t)(row0 + ai * 128 + m * 16) * 2048 + c;
                    f32x4 p0, p1; unpack8(*(const u32x4*)(pe + o), p0, p1);
                    f32x4 v0 = acc[ai][bj][m][0] + b0, v1 = acc[ai][bj][m][1] + b1;
#pragma unroll
                    for (int j = 0; j < 4; ++j) { v0[j] = sigmoidf_(v0[j]); v1[j] = sigmoidf_(v1[j]); }
                    const f32x4 r0 = *(const f32x4*)(r + o) + v0 * p0, r1 = *(const f32x4*)(r + o + 4) + v1 * p1;
                    *(f32x4*)(r + o) = r0; *(f32x4*)(r + o + 4) = r1; __builtin_amdgcn_sched_barrier(0); } }
    }
};

__device__ __forceinline__ int win_srccol(int vr) {
    if (vr < 4096) { const int pn = vr >> 8, rr = vr & 255; return rr < 128 ? pn * 128 + rr : 2048 + pn * 128 + (rr - 128); }
    if (vr < 6144) return 6144 + (vr - 4096);
    if (vr < 7168) return 8192 + (vr - 6144);
    if (vr < 8192) return 9216 + (vr - 7168);
    if (vr < 9216) return 11264 + (vr - 8192);
    if (vr < 11264) return 4096 + (vr - 9216);
    return 10240 + (vr - 11264);
}
__device__ __forceinline__ void transpose_item(const float* W, int K, int N, bf16_t* WT, int k0, int scol0, int drow0, LAS float* scr, int lane) {
#pragma unroll 8
    for (int i = 0; i < 32; ++i) { const int kk = 2 * i + (lane >> 5); scr[kk * 33 + (lane & 31)] = W[(size_t)(k0 + kk) * N + scol0 + (lane & 31)]; }
    __builtin_amdgcn_s_waitcnt(0xc07f); asm volatile("" ::: "memory");
    const int c = lane & 7;
#pragma unroll
    for (int j = 0; j < 4; ++j) { const int n = (lane >> 3) + 8 * j; const LAS float* s = scr + (8 * c) * 33 + n;
        u32x4 o; o.x = pk2(s[0 * 33], s[1 * 33]); o.y = pk2(s[2 * 33], s[3 * 33]); o.z = pk2(s[4 * 33], s[5 * 33]); o.w = pk2(s[6 * 33], s[7 * 33]);
        *(u32x4*)(WT + (size_t)(drow0 + n) * K + k0 + 8 * c) = o; }
    __builtin_amdgcn_s_waitcnt(0xc07f); asm volatile("" ::: "memory");
}
__device__ __forceinline__ void phase0(const Params& P, LAS unsigned char* lds) {
    const int tid = tid_opaque(), wave = tid >> 6, lane = tid & 63;
    const int gw = blockIdx.x * 8 + wave, NGW = gridDim.x * 8;
    bf16_t* H = (bf16_t*)(P.ws + WS_H); float* stats = (float*)(P.ws + WS_STATS);
    LAS float* scr = (LAS float*)(lds + wave * 16384);
    constexpr int I_IN = 32 * 384, I_M = 32 * 128;
    for (int it = gw; it < I_IN + I_M; it += NGW) {
        int r = it;
        if (r < I_IN) { const int kb = r / 384, nb = r % 384; transpose_item(P.w_in, 2048, 12288, (bf16_t*)(P.ws + WS_WTMAIN), 64 * kb, win_srccol(32 * nb), 32 * nb, scr, lane); continue; } r -= I_IN;
        { const int kb = r / 128, nb = r % 128; transpose_item(P.w_merge, 2048, 4096, (bf16_t*)(P.ws + WS_WMT), 64 * kb, 32 * nb, 32 * nb, scr, lane); }
    }
    for (int row = gw; row < TOK; row += 2 * NGW) {
        const int row2 = row + NGW;
        const f32x4* xa = (const f32x4*)(P.x + (size_t)row * DM) + lane; const f32x4* xb = (const f32x4*)(P.x + (size_t)row2 * DM) + lane;
        f32x4 va[8], vb[8]; float sa = 0.f, sb = 0.f;
#pragma unroll
        for (int j = 0; j < 8; ++j) { va[j] = xa[64 * j]; vb[j] = xb[64 * j]; }
#pragma unroll
        for (int j = 0; j < 8; ++j) { sa += (va[j][0] + va[j][1]) + (va[j][2] + va[j][3]); sb += (vb[j][0] + vb[j][1]) + (vb[j][2] + vb[j][3]); }
        const float ma = wave_sum(sa, lane) * (1.f / DM), mb = wave_sum(sb, lane) * (1.f / DM); float qa = 0.f, qb = 0.f;
#pragma unroll
        for (int j = 0; j < 8; ++j) { va[j] = va[j] - ma; vb[j] = vb[j] - mb;
            qa += (va[j][0] * va[j][0] + va[j][1] * va[j][1]) + (va[j][2] * va[j][2] + va[j][3] * va[j][3]);
            qb += (vb[j][0] * vb[j][0] + vb[j][1] * vb[j][1]) + (vb[j][2] * vb[j][2] + vb[j][3] * vb[j][3]); }
        const float ra = 1.f / sqrtf(wave_sum(qa, lane) * (1.f / DM) + LN_EPS), rb = 1.f / sqrtf(wave_sum(qb, lane) * (1.f / DM) + LN_EPS);
        u32x2* oa = (u32x2*)(H + (size_t)row * DM) + lane; u32x2* ob = (u32x2*)(H + (size_t)row2 * DM) + lane;
#pragma unroll
        for (int j = 0; j < 8; ++j) { const f32x4 g = *((const f32x4*)P.ln_in_g + lane + 64 * j), bb = *((const f32x4*)P.ln_in_b + lane + 64 * j);
            const f32x4 ya = va[j] * ra * g + bb, yb = vb[j] * rb * g + bb;
            u32x2 wa; wa.x = pk2(ya[0], ya[1]); wa.y = pk2(ya[2], ya[3]); oa[64 * j] = wa;
            u32x2 wb; wb.x = pk2(yb[0], yb[1]); wb.y = pk2(yb[2], yb[3]); ob[64 * j] = wb; }
        if (lane == 0) { stats[2 * row] = ma; stats[2 * row + 1] = ra; stats[2 * row2] = mb; stats[2 * row2 + 1] = rb; }
    }
}

__device__ __forceinline__ void late_transposes(const Params& P, LAS unsigned char* lds, int blk0) {
    const int tid = tid_opaque(), wave = tid >> 6, lane = tid & 63;
    const int gw = ((int)blockIdx.x - blk0) * 8 + wave, NGW = ((int)gridDim.x - blk0) * 8;
    LAS float* scr = (LAS float*)(lds + wave * 16384);
    constexpr int I_A = 32 * 64, I_B = 16 * 64, I_O = 32 * 64, I_PG = 32 * 64, I_PE = 4 * 64;
    for (int it = gw; it < I_A + I_B + I_O + I_PG + I_PE; it += NGW) {
        int r = it;
        if (r < I_A) { const int kb = r / 64, nb = r % 64; transpose_item(P.w_br_hg, 2048, 2048, (bf16_t*)(P.ws + WS_WAT), 64 * kb, 32 * nb, 32 * nb, scr, lane); continue; } r -= I_A;
        if (r < I_B) { const int kb = r / 64, nb = r % 64; transpose_item(P.w_br_sb, 1024, 2048, (bf16_t*)(P.ws + WS_WBT), 64 * kb, 32 * nb, 32 * nb, scr, lane); continue; } r -= I_B;
        if (r < I_O) { const int kb = r / 64, nb = r % 64; transpose_item(P.w_out, 2048, 2048, (bf16_t*)(P.ws + WS_WOT), 64 * kb, 32 * nb, 32 * nb, scr, lane); continue; } r -= I_O;
        if (r < I_PG) { const int kb = r / 64, nb = r % 64; transpose_item(P.w_pg, 2048, 2048, (bf16_t*)(P.ws + WS_WPGT), 64 * kb, 32 * nb, 32 * nb, scr, lane); continue; } r -= I_PG;
        { const int kb = r / 64, nb = r % 64; transpose_item(P.w_pe, 256, 2048, (bf16_t*)(P.ws + WS_WPET), 64 * kb, 32 * nb, 32 * nb, scr, lane); }
    }
    { const f32x4* ps = (const f32x4*)P.p; u32x4* pd = (u32x4*)(P.ws + WS_PB);
      for (size_t i = (size_t)((int)blockIdx.x - blk0) * 512 + tid; i < (size_t)TOK * 256 / 8; i += (size_t)((int)gridDim.x - blk0) * 512) { const f32x4 a = ps[2 * i], b = ps[2 * i + 1]; pd[i] = pack8(a, b); } }
    __syncthreads();
}

constexpr int HL_QD = 0, HL_KI = 17408, HL_KET = 34816, HL_VT = 53248, HL_ST = 71680, HL_RED = 106496, HL_HGT = 108032, HL_DEC = 125440, HL_HGT2 = 125952;
#define LDS_BARRIER() do { asm volatile("s_waitcnt lgkmcnt(0)" ::: "memory"); __builtin_amdgcn_s_barrier(); asm volatile("" ::: "memory"); } while (0)
__device__ __forceinline__ void hgrn2_seq(const Params& P, LAS unsigned char* lds, float* outbuf, int item) {
    const int tid = tid_opaque(), w = __builtin_amdgcn_readfirstlane(tid >> 6), lane = tid & 63, r = lane & 31, h = lane >> 5;
    const int tb = w >> 2, vb = w & 3, kb = w >> 1, vb2 = 2 * (w & 1);
    const int b = item >> 4, head = item & 15, hbase = head * 128; const size_t tokbase = (size_t)b * SEQ_T;
    const bf16_t* QD = (const bf16_t*)(P.ws + WS_QD); const bf16_t* KI = (const bf16_t*)outbuf; const bf16_t* KET = (const bf16_t*)outbuf + (size_t)TOK * 2048;
    const bf16_t* VT = (const bf16_t*)(P.ws + WS_VT); bf16_t* HG = (bf16_t*)(P.ws + WS_HG); const float* DEC = (const float*)(P.ws + WS_DEC);
    LAS float* RED = (LAS float*)(lds + HL_RED);
    f32x16 S[2];
#pragma unroll
    for (int q = 0; q < 2; ++q)
#pragma unroll
        for (int i = 0; i < 16; ++i) S[q][i] = 0.f;
    if (tid < 128) ((LAS float*)(lds + HL_RED + 1024))[tid] = P.hg_norm_g[hbase + tid];
    const LAS float* gnp = (const LAS float*)(lds + HL_RED + 1024) + 32 * vb + 4 * h;
    const int idA0 = tid, idA1 = tid + 512;
    const int rA0 = idA0 >> 4, cA0 = idA0 & 15, rA1 = idA1 >> 4, cA1 = idA1 & 15;
    const int rT0 = idA0 >> 3, cT0 = idA0 & 7, rT1 = idA1 >> 3, cT1 = idA1 & 7;
    u32x4 pf[10]; float pfd = 0.f;
#define HG_LOAD_PF(c) do { const size_t t0 = tokbase + 64 * (size_t)(c); \
        pf[0] = *(const u32x4*)(QD + (t0 + rA0) * 2048 + hbase + 8 * cA0); pf[1] = *(const u32x4*)(QD + (t0 + rA1) * 2048 + hbase + 8 * cA1); \
        pf[2] = *(const u32x4*)(KI + (t0 + rA0) * 2048 + hbase + 8 * cA0); pf[3] = *(const u32x4*)(KI + (t0 + rA1) * 2048 + hbase + 8 * cA1); \
        pf[4] = *(const u32x4*)(KET + ((t0 >> 6) * 2048 + hbase + rT0) * 64 + 8 * cT0); pf[5] = *(const u32x4*)(KET + ((t0 >> 6) * 2048 + hbase + rT1) * 64 + 8 * cT1); \
        pf[6] = *(const u32x4*)(VT + ((t0 >> 6) * 3072 + hbase + rT0) * 64 + 8 * cT0); pf[7] = *(const u32x4*)(VT + ((t0 >> 6) * 3072 + hbase + rT1) * 64 + 8 * cT1); \
        pf[8] = *(const u32x4*)(HG + (t0 + rA0) * 2048 + hbase + 8 * cA0); pf[9] = *(const u32x4*)(HG + (t0 + rA1) * 2048 + hbase + 8 * cA1); \
        if (tid < 128) pfd = DEC[(t0 >> 6) * 2048 + hbase + tid]; } while (0)
    HG_LOAD_PF(0);
#pragma unroll 1
    for (int c = 0; c < 256; ++c) {
        *(LAS u32x4*)(lds + HL_QD + rA0 * 272 + cA0 * 16) = pf[0]; *(LAS u32x4*)(lds + HL_QD + rA1 * 272 + cA1 * 16) = pf[1];
        *(LAS u32x4*)(lds + HL_KI + rA0 * 272 + cA0 * 16) = pf[2]; *(LAS u32x4*)(lds + HL_KI + rA1 * 272 + cA1 * 16) = pf[3];
        *(LAS u32x4*)(lds + HL_KET + rT0 * 144 + cT0 * 16) = pf[4]; *(LAS u32x4*)(lds + HL_KET + rT1 * 144 + cT1 * 16) = pf[5];
        *(LAS u32x4*)(lds + HL_VT + rT0 * 144 + cT0 * 16) = pf[6]; *(LAS u32x4*)(lds + HL_VT + rT1 * 144 + cT1 * 16) = pf[7];
        const int hgt_off = (c & 1) ? HL_HGT2 : HL_HGT;
        *(LAS u32x4*)(lds + hgt_off + rA0 * 272 + cA0 * 16) = pf[8]; *(LAS u32x4*)(lds + hgt_off + rA1 * 272 + cA1 * 16) = pf[9];
        if (tid < 128) ((LAS float*)(lds + HL_DEC))[tid] = pfd;
#pragma unroll
        for (int q = 0; q < 2; ++q)
#pragma unroll
            for (int g = 0; g < 4; ++g) { u32x2 v; v.x = pk2(S[q][4 * g], S[q][4 * g + 1]); v.y = pk2(S[q][4 * g + 2], S[q][4 * g + 3]);
                *(LAS u32x2*)(lds + HL_ST + (32 * (vb2 + q) + r) * 272 + (32 * kb + 8 * g + 4 * h) * 2) = v; }
        LDS_BARRIER();
        const size_t tok = tokbase + 64 * (size_t)c + 32 * tb + r;
        bf16_t* hgp = HG + tok * 2048 + hbase + 32 * vb + 4 * h;
        if (c + 1 < 256) HG_LOAD_PF(c + 1);
        bf16x8 qf[8];
#pragma unroll
        for (int st = 0; st < 8; ++st) qf[st] = *(const LAS bf16x8*)(lds + HL_QD + (32 * tb + r) * 272 + (16 * st + 8 * h) * 2);
        f32x16 o;
#pragma unroll
        for (int i = 0; i < 16; ++i) o[i] = 0.f;
#pragma unroll 1
        for (int sb = 0; sb <= tb; ++sb) {
            bf16x8 kf[8];
#pragma unroll
            for (int st = 0; st < 8; ++st) kf[st] = *(const LAS bf16x8*)(lds + HL_KI + (32 * sb + r) * 272 + (16 * st + 8 * h) * 2);
            u32x4 vf[2];
#pragma unroll
            for (int u = 0; u < 2; ++u) { const LAS unsigned char* vp = lds + HL_VT + (32 * vb + r) * 144 + (32 * sb + 16 * u + 4 * h) * 2;
                const u32x2 lo = *(const LAS u32x2*)vp, hi = *(const LAS u32x2*)(vp + 16); vf[u].x = lo.x; vf[u].y = lo.y; vf[u].z = hi.x; vf[u].w = hi.y; }
            __builtin_amdgcn_sched_barrier(0);
            f32x16 a0, a1;
#pragma unroll
            for (int i = 0; i < 16; ++i) { a0[i] = 0.f; a1[i] = 0.f; }
#pragma unroll
            for (int st = 0; st < 4; ++st) { a0 = MFMA32(kf[st], qf[st], a0); a1 = MFMA32(kf[st + 4], qf[st + 4], a1); }
            f32x16 a = a0 + a1;
            if (sb == tb) {
#pragma unroll
                for (int i = 0; i < 16; ++i) a[i] = (crow(i, h) <= r) ? a[i] : 0.f;
            }
#pragma unroll
            for (int u = 0; u < 2; ++u) {
                u32x4 pa; pa.x = pk2(a[8 * u], a[8 * u + 1]); pa.y = pk2(a[8 * u + 2], a[8 * u + 3]); pa.z = pk2(a[8 * u + 4], a[8 * u + 5]); pa.w = pk2(a[8 * u + 6], a[8 * u + 7]);
                o = MFMA32(__builtin_bit_cast(bf16x8, vf[u]), __builtin_bit_cast(bf16x8, pa), o);
            }
        }
        {
            bf16x8 sf[8];
#pragma unroll
            for (int st = 0; st < 8; ++st) sf[st] = *(const LAS bf16x8*)(lds + HL_ST + (32 * vb + r) * 272 + (16 * st + 8 * h) * 2);
            __builtin_amdgcn_sched_barrier(0);
            f32x16 o1;
#pragma unroll
            for (int i = 0; i < 16; ++i) o1[i] = 0.f;
#pragma unroll
            for (int st = 0; st < 4; ++st) { o = MFMA32(sf[st], qf[st], o); o1 = MFMA32(sf[st + 4], qf[st + 4], o1); }
            o = o + o1;
        }
        float ss = 0.f;
#pragma unroll
        for (int i = 0; i < 16; ++i) ss += o[i] * o[i];
        ss += lane_read(ss, lane ^ 32);
        if (h == 0) RED[vb * 64 + 32 * tb + r] = ss;
        {
            bf16x8 kef[4], vf2[2][4];
#pragma unroll
            for (int u = 0; u < 4; ++u) { kef[u] = *(const LAS bf16x8*)(lds + HL_KET + (32 * kb + r) * 144 + (16 * u + 8 * h) * 2);
#pragma unroll
                for (int q = 0; q < 2; ++q) vf2[q][u] = *(const LAS bf16x8*)(lds + HL_VT + (32 * (vb2 + q) + r) * 144 + (16 * u + 8 * h) * 2); }
#pragma unroll
            for (int g = 0; g < 4; ++g) { const f32x4 dvg = *(const LAS f32x4*)(lds + HL_DEC + (32 * kb + 8 * g + 4 * h) * 4);
#pragma unroll
                for (int q = 0; q < 2; ++q)
#pragma unroll
                    for (int e = 0; e < 4; ++e) S[q][4 * g + e] *= dvg[e]; }
            __builtin_amdgcn_sched_barrier(0);
#pragma unroll
            for (int u = 0; u < 4; ++u) { S[0] = MFMA32(kef[u], vf2[0][u], S[0]); S[1] = MFMA32(kef[u], vf2[1][u], S[1]); }
        }
        LDS_BARRIER();
        const float tot = RED[32 * tb + r] + RED[64 + 32 * tb + r] + RED[128 + 32 * tb + r] + RED[192 + 32 * tb + r];
        const float rstd = 1.f / sqrtf(tot * (1.f / 128.f) + LN_EPS);
#pragma unroll
        for (int g = 0; g < 4; ++g) {
            const u32x2 hgvg = *(const LAS u32x2*)(lds + hgt_off + (32 * tb + r) * 272 + (32 * vb + 8 * g + 4 * h) * 2);
            const float g0 = bf_lo(hgvg.x), g1 = bf_hi(hgvg.x), g2 = bf_lo(hgvg.y), g3 = bf_hi(hgvg.y);
            const f32x4 gn = *(const LAS f32x4*)(gnp + 8 * g);
            const float y0 = o[4 * g] * rstd * gn[0] * (g0 * sigmoidf_(g0)), y1 = o[4 * g + 1] * rstd * gn[1] * (g1 * sigmoidf_(g1));
            const float y2 = o[4 * g + 2] * rstd * gn[2] * (g2 * sigmoidf_(g2)), y3 = o[4 * g + 3] * rstd * gn[3] * (g3 * sigmoidf_(g3));
            u32x2 wv; wv.x = pk2(y0, y1); wv.y = pk2(y2, y3); *(u32x2*)(hgp + 8 * g) = wv;
        }
    }
#undef HG_LOAD_PF
}

__device__ __forceinline__ void sb_attention(const Params& P, int blk0) {
    const int tid_ = tid_opaque(); const int gwave = ((int)blockIdx.x - blk0) * 8 + __builtin_amdgcn_readfirstlane(tid_ >> 6), nwaves = ((int)gridDim.x - blk0) * 8;
    const int lane = tid_ & 63, r = lane & 31, h = lane >> 5;
    const bf16_t* SQ = (const bf16_t*)(P.ws + WS_SQ); const bf16_t* SK = (const bf16_t*)(P.ws + WS_SK); const bf16_t* SG = (const bf16_t*)(P.ws + WS_SG);
    const bf16_t* VT = (const bf16_t*)(P.ws + WS_VT);
    const float scale = 0.08838834764831845f;
    for (int item = gwave; item < 8192; item += nwaves) {
        const int qt = item & 511, hd = (item >> 9) & 7, b = item >> 12;
        const size_t tokbase = (size_t)b * SEQ_T;
        const bf16_t* qrow = SQ + (tokbase + 32 * qt + r) * 1024 + hd * 128 + 8 * h;
        bf16x8 qf[8];
#pragma unroll
        for (int st = 0; st < 8; ++st) qf[st] = *(const bf16x8*)(qrow + 16 * st);
        f32x16 o[4];
#pragma unroll
        for (int d = 0; d < 4; ++d)
#pragma unroll
            for (int i = 0; i < 16; ++i) o[d][i] = 0.f;
        float R = 0.f;
        bf16x8 kf[8], kfn[8]; u32x4 vf[4][2];
#define SB_LOAD_K(KF, kt_) do { \
            const bf16_t* krow_ = SK + (tokbase + 32 * (kt_) + r) * 1024 + hd * 128 + 8 * h; \
            _Pragma("unroll") for (int st = 0; st < 8; ++st) KF[st] = *(const bf16x8*)(krow_ + 16 * st); } while (0)
#define SB_LOAD_V(VF, kt_) do { \
            const bf16_t* vbase_ = VT + ((size_t)(b * 256 + ((kt_) >> 1)) * 3072 + 2048 + hd * 128 + r) * 64 + ((kt_) & 1) * 32 + 4 * h; \
            _Pragma("unroll") for (int d = 0; d < 4; ++d) _Pragma("unroll") for (int u = 0; u < 2; ++u) { const bf16_t* vp_ = vbase_ + d * 32 * 64 + 16 * u; \
                const u32x2 lo_ = *(const u32x2*)vp_, hi_ = *(const u32x2*)(vp_ + 8); VF[d][u].x = lo_.x; VF[d][u].y = lo_.y; VF[d][u].z = hi_.x; VF[d][u].w = hi_.y; } } while (0)
        SB_LOAD_K(kf, qt);
#pragma unroll 1
        for (int kt = qt; kt >= 0; --kt) {
            SB_LOAD_V(vf, kt);
            if (kt > 0) SB_LOAD_K(kfn, kt - 1);
            f32x16 s;
#pragma unroll
            for (int i = 0; i < 16; ++i) s[i] = 0.f;
#pragma unroll
            for (int st = 0; st < 8; ++st) s = MFMA32(kf[st], qf[st], s);
            const bool diag = (kt == qt);
            float l[16];
#pragma unroll
            for (int i = 0; i < 16; ++i) { const float z = s[i] * scale; s[i] = z; const float sp = fmaxf(z, 0.f) + fast_log(1.f + fast_exp(-fabsf(z)));
                const bool valid = !diag || (crow(i, h) < r); l[i] = valid ? -sp : 0.f; }
            float G[4], Hs[4], T[4];
#pragma unroll
            for (int g = 0; g < 4; ++g) { G[g] = (l[4 * g] + l[4 * g + 1]) + (l[4 * g + 2] + l[4 * g + 3]); Hs[g] = lane_read(G[g], lane ^ 32); T[g] = G[g] + Hs[g]; }
            float Bs[4]; Bs[3] = 0.f; Bs[2] = T[3]; Bs[1] = T[3] + T[2]; Bs[0] = Bs[1] + T[1];
            const float total = Bs[0] + T[0];
            float A[16];
#pragma unroll
            for (int g = 0; g < 4; ++g) {
                const float off = R + Bs[g] + (h == 0 ? Hs[g] : 0.f);
                const float c3 = off, c2 = c3 + l[4 * g + 3], c1 = c2 + l[4 * g + 2], c0 = c1 + l[4 * g + 1];
                const float cc[4] = {c0, c1, c2, c3};
#pragma unroll
                for (int e = 0; e < 4; ++e) { const int i = 4 * g + e; const bool valid = !diag || (crow(i, h) < r); const float a = fast_exp(s[i] + l[i] + cc[e]); A[i] = valid ? a : 0.f; }
            }
            R += total;
#pragma unroll
            for (int u = 0; u < 2; ++u) {
                u32x4 pa; pa.x = pk2(A[8 * u], A[8 * u + 1]); pa.y = pk2(A[8 * u + 2], A[8 * u + 3]); pa.z = pk2(A[8 * u + 4], A[8 * u + 5]); pa.w = pk2(A[8 * u + 6], A[8 * u + 7]);
#pragma unroll
                for (int d = 0; d < 4; ++d) o[d] = MFMA32(__builtin_bit_cast(bf16x8, vf[d][u]), __builtin_bit_cast(bf16x8, pa), o[d]);
            }
            if (__all(R < -104.f)) break;
#pragma unroll
            for (int st = 0; st < 8; ++st) kf[st] = kfn[st];
        }
#undef SB_LOAD_K
#undef SB_LOAD_V
        const bf16_t* sgp = SG + (tokbase + 32 * qt + r) * 1024 + hd * 128 + 4 * h; bf16_t* ybp = (bf16_t*)(P.ws + WS_YB) + (tokbase + 32 * qt + r) * 1024 + hd * 128 + 4 * h;
#pragma unroll
        for (int d = 0; d < 4; ++d)
#pragma unroll
            for (int g = 0; g < 4; ++g) { const bf16_t* pp = sgp + 32 * d + 8 * g; const u32x2 gv = *(const u32x2*)pp;
                const float g0 = bf_lo(gv.x), g1 = bf_hi(gv.x), g2 = bf_lo(gv.y), g3 = bf_hi(gv.y);
                u32x2 wv; wv.x = pk2(o[d][4 * g] * (g0 * sigmoidf_(g0)), o[d][4 * g + 1] * (g1 * sigmoidf_(g1)));
                wv.y = pk2(o[d][4 * g + 2] * (g2 * sigmoidf_(g2)), o[d][4 * g + 3] * (g3 * sigmoidf_(g3))); *(u32x2*)(ybp + 32 * d + 8 * g) = wv; }
    }
}

__device__ __forceinline__ void final_ln(const Params& P) {
    const int tid = tid_opaque(), wave = tid >> 6, lane = tid & 63;
    const int nw = gridDim.x * 8;
    for (int row = blockIdx.x * 8 + wave; row < TOK; row += 2 * nw) {
        const int row2 = row + nw;
        f32x4* xa = (f32x4*)(P.out + (size_t)row * DM) + lane; f32x4* xb = (f32x4*)(P.out + (size_t)row2 * DM) + lane;
        f32x4 va[8], vb[8]; float sa = 0.f, sb = 0.f;
#pragma unroll
        for (int j = 0; j < 8; ++j) { va[j] = xa[64 * j]; vb[j] = xb[64 * j]; }
#pragma unroll
        for (int j = 0; j < 8; ++j) { sa += (va[j][0] + va[j][1]) + (va[j][2] + va[j][3]); sb += (vb[j][0] + vb[j][1]) + (vb[j][2] + vb[j][3]); }
        const float ma = wave_sum(sa, lane) * (1.f / DM), mb = wave_sum(sb, lane) * (1.f / DM); float qa = 0.f, qb = 0.f;
#pragma unroll
        for (int j = 0; j < 8; ++j) { va[j] = va[j] - ma; vb[j] = vb[j] - mb;
            qa += (va[j][0] * va[j][0] + va[j][1] * va[j][1]) + (va[j][2] * va[j][2] + va[j][3] * va[j][3]);
            qb += (vb[j][0] * vb[j][0] + vb[j][1] * vb[j][1]) + (vb[j][2] * vb[j][2] + vb[j][3] * vb[j][3]); }
        const float ra = 1.f / sqrtf(wave_sum(qa, lane) * (1.f / DM) + LN_EPS), rb = 1.f / sqrtf(wave_sum(qb, lane) * (1.f / DM) + LN_EPS);
#pragma unroll
        for (int j = 0; j < 8; ++j) { const f32x4 g = *((const f32x4*)P.ln_g + lane + 64 * j), bb = *((const f32x4*)P.ln_b + lane + 64 * j);
            xa[64 * j] = va[j] * ra * g + bb; xb[64 * j] = vb[j] * rb * g + bb; }
    }
}

#define XB_TMO      128
#define XB_XCNT(j)  (256  + 64 * (j))
#define XB_XSUB(j)  (1280 + 64 * (j))
#define XB_XGEN(j)  (2304 + 64 * (j))
#define XB_TOP      3328
#define XB_TOPGEN   3392
#define XCD_BAR_WORDS 3456
#define XB_SPIN_CAP (1u << 18)
__device__ __forceinline__ unsigned xb_ld(unsigned* p)              { return __hip_atomic_load(p, __ATOMIC_RELAXED, __HIP_MEMORY_SCOPE_AGENT); }
__device__ __forceinline__ unsigned xb_add(unsigned* p, unsigned v) { return __hip_atomic_fetch_add(p, v, __ATOMIC_RELAXED, __HIP_MEMORY_SCOPE_AGENT); }
__device__ __forceinline__ unsigned xb_xcc_id() { return (unsigned)__builtin_amdgcn_s_getreg((3 << 11) | 20) & 0xFu; }
#define XB_SPIN(cond, bar) do { unsigned _sp = 0; while (cond) { __builtin_amdgcn_s_sleep(1); \
    if ((++_sp & 255u) == 0u) { if (xb_ld(&(bar)[XB_TMO])) break; if (_sp > XB_SPIN_CAP) { atomicAdd(&(bar)[XB_TMO], 1u); break; } } } } while (0)
__device__ __forceinline__ void xcd_barrier_complete(unsigned* bar, unsigned x, unsigned& nloc, unsigned& nx) {
    const unsigned G = gridDim.x * gridDim.y * gridDim.z;
    unsigned sum, cnt, mine, sp = 0u;
    for (;;) {
        sum = 0u; cnt = 0u; mine = 0u;
#pragma unroll
        for (unsigned j = 0; j < 16; ++j) { const unsigned c = xb_ld(&bar[XB_XCNT(j)]); sum += c; cnt += (c > 0u) ? 1u : 0u; mine = (j == x) ? c : mine; }
        if (sum == G) break;
        __builtin_amdgcn_s_sleep(1);
        if ((++sp & 255u) == 0u) { if (xb_ld(&bar[XB_TMO])) break; if (sp > XB_SPIN_CAP) { atomicAdd(&bar[XB_TMO], 1u); break; } }
    }
    nloc = mine > 0u ? mine : 1u; nx = cnt > 0u ? cnt : 1u;
}
__device__ __forceinline__ void xcd_barrier(unsigned* bar, volatile LAS unsigned* st) {
    asm volatile("s_waitcnt vmcnt(0)" ::: "memory");
    __syncthreads();
    if (tid_opaque() == 0) {
        const unsigned x = xb_xcc_id();
        __builtin_amdgcn_s_waitcnt(0);
        unsigned nloc = st[0], nx = st[1];
        if (nloc == 0u) { xcd_barrier_complete(bar, x, nloc, nx); st[0] = nloc; st[1] = nx; }
        const unsigned old = xb_add(&bar[XB_XSUB(x)], 1u);
        const unsigned gen = old / nloc;
        if (old + 1u == (gen + 1u) * nloc) {
            __builtin_amdgcn_fence(__ATOMIC_RELEASE, "agent");
            asm volatile("s_waitcnt vmcnt(0)" ::: "memory");
            const unsigned og = xb_add(&bar[XB_TOP], 1u);
            const unsigned tg = og / nx;
            if (og + 1u == (tg + 1u) * nx) xb_add(&bar[XB_TOPGEN], 1u);
            else XB_SPIN(xb_ld(&bar[XB_TOPGEN]) == tg, bar);
            __builtin_amdgcn_fence(__ATOMIC_ACQUIRE, "agent");
            xb_add(&bar[XB_XGEN(x)], 1u);
            asm volatile("s_waitcnt vmcnt(0)" ::: "memory");
        } else {
            XB_SPIN(xb_ld(&bar[XB_XGEN(x)]) == gen, bar);
            __builtin_amdgcn_fence(__ATOMIC_ACQUIRE, "agent");
            asm volatile("s_waitcnt vmcnt(0)" ::: "memory");
        }
    }
    __syncthreads();
}

__device__ __forceinline__ void subgrid_barrier(unsigned* bar, unsigned n) {
    asm volatile("s_waitcnt vmcnt(0)" ::: "memory");
    __syncthreads();
    if (tid_opaque() == 0) {
        __builtin_amdgcn_s_waitcnt(0);
        __builtin_amdgcn_fence(__ATOMIC_RELEASE, "agent");
        asm volatile("s_waitcnt vmcnt(0)" ::: "memory");
        (void)xb_add(&bar[0], 1u);
        XB_SPIN(xb_ld(&bar[0]) < n, bar);
        __builtin_amdgcn_fence(__ATOMIC_ACQUIRE, "agent");
        asm volatile("s_waitcnt vmcnt(0)" ::: "memory");
    }
    __syncthreads();
}

struct EpiU {
    static constexpr bool PERM = true;
    int mode; const Params* Pp;
    __device__ __forceinline__ void operator()(AccRef acc, const Unit& u, int wr, int wc, int fr, int fq) const {
        const Params& P = *Pp; unsigned char* ws = P.ws;
        switch (mode) {
        case 0: { EpiProj E; E.QD = (bf16_t*)(ws + WS_QD); E.KI = (bf16_t*)P.out; E.KET = (bf16_t*)P.out + (size_t)TOK * 2048; E.HG = (bf16_t*)(ws + WS_HG); E.SQ = (bf16_t*)(ws + WS_SQ);
                  E.SK = (bf16_t*)(ws + WS_SK); E.SG = (bf16_t*)(ws + WS_SG); E.DEC = (float*)(ws + WS_DEC); E.lbl = P.lb_logits; E(acc, u, wr, wc, fr, fq); } break;
        case 1: { EpiVT E; E.dst = (bf16_t*)(ws + WS_VT); E(acc, u, wr, wc, fr, fq); } break;
        case 2: { EpiGate E; E.ga = ws + WS_GA; E.gb = ws + WS_GB; E.bias = P.b_merge; E(acc, u, wr, wc, fr, fq); } break;
        case 3: { EpiMul E; E.m1 = (bf16_t*)(ws + WS_SQ); E.G = ws + WS_GB; E(acc, u, wr, wc, fr, fq); } break;
        case 4: { EpiMulAdd E; E.mo = (bf16_t*)(ws + WS_SQ); E.m1 = (const bf16_t*)(ws + WS_SQ); E.G = ws + WS_GA; E(acc, u, wr, wc, fr, fq); } break;
        case 6: { EpiOut E; E.r = P.out; E.rb = (bf16_t*)(ws + WS_QD); E.x = P.x; E.stats = (const float*)(ws + WS_STATS); E.g = P.ln_in_g; E.b = P.ln_in_b; E(acc, u, wr, wc, fr, fq); } break;
        case 7: { EpiPlain E; E.dst = (bf16_t*)(ws + WS_VT); E.ld = 2048; E(acc, u, wr, wc, fr, fq); } break;
        default: { EpiFinal E; E.r = P.out; E.pe = (const bf16_t*)(ws + WS_VT); E.bias = P.b_pg; E(acc, u, wr, wc, fr, fq); } break;
        }
    }
};
__device__ __forceinline__ void gemm_job(const Params& P, int job, LAS unsigned char* lds, int G, int c) {
    unsigned char* ws = P.ws;
    size_t a, b; int M = TOK, N = 2048, K = 2048;
    switch (job) {
    case 0: a = WS_H; b = WS_WTMAIN; N = 9216; break;
    case 1: a = WS_WTVT; b = WS_H; M = 3072; N = TOK; break;
    case 2: a = WS_H; b = WS_WMT; N = 4096; break;
    case 3: a = WS_YB; b = WS_WBT; K = 1024; break;
    case 4: a = WS_HG; b = WS_WAT; break;
    case 6: a = WS_SQ; b = WS_WOT; break;
    case 7: a = WS_PB; b = WS_WPET; K = 256; break;
    default: a = WS_QD; b = WS_WPGT; break;
    }
    pg8::Gemm g{(const bf16_t*)(ws + a), (const bf16_t*)(ws + b), M, N, K};
    pg8::StaticOrder S; S.init(M, N, G, c);
    EpiU E; E.mode = job; E.Pp = &P;
    pg8::gemm_phase(lds, g, S, E);
}
__device__ __forceinline__ void run_phase(const Params& P, int ph, LAS unsigned char* lds) {
    int j0 = 0, j1 = 0, G = (int)gridDim.x, c = (int)blockIdx.x;
    if (ph == 0) { phase0(P, lds); }
    else if (ph == 2) {
        if (c < 32) hgrn2_seq(P, lds, P.out, c);
        else { late_transposes(P, lds, 32); sb_attention(P, 32); j0 = 2; j1 = 4; G -= 32; c -= 32; }
    }
    else if (ph == 6) { final_ln(P); }
    else if (ph == 1) { j0 = 0; j1 = 2; }
    else if (ph == 3) { j0 = 4; j1 = 5; }
    else if (ph == 4) { j0 = 6; j1 = 7; }
    else { j0 = 7; j1 = 9; }
#pragma unroll 1
    for (int j = j0; j < j1; ++j) {
        if (ph == 2 && j == 3) subgrid_barrier((unsigned*)(P.ws + WS_BAR), (unsigned)G);
        gemm_job(P, j, lds, G, c);
    }
}
#ifndef MK_PROG
#define MK_PROG 0, 1, 2, 3, 4, 5, 6
#endif
__device__ __constant__ const int PROG_D[] = {MK_PROG};
static const int PROG_H[] = {MK_PROG};
constexpr int NPHASES = sizeof(PROG_H) / sizeof(int);
constexpr int LDS_BYTES = 147456 + 16;

constexpr int LDS_XB = 147456;
template <bool COOP> __global__ __launch_bounds__(512, 2) void mega(Params P) {
    extern __shared__ __attribute__((aligned(16))) unsigned char shm[];
    LAS unsigned char* lds = (LAS unsigned char*)shm;
    unsigned* bar = (unsigned*)(P.ws + WS_BAR);
    volatile LAS unsigned* st = (volatile LAS unsigned*)(lds + LDS_XB);
    if constexpr (COOP) {
        if (tid_opaque() == 0) { st[0] = 0u; st[1] = 0u; (void)xb_add(&bar[XB_XCNT(xb_xcc_id())], 1u); }
        __syncthreads();
        if (P.ph_hi < 0) cg::this_grid().sync();
    }
#pragma unroll 1
    for (int pi = P.ph_lo; pi < P.ph_hi; ++pi) {
        const int ph = PROG_D[pi];
        run_phase(P, ph, lds);
        if constexpr (COOP) { if (pi + 1 < P.ph_hi) xcd_barrier(bar, st); }
    }
}

extern "C" void kernel_launch(void* const* d_in, const int* in_sizes, int n_in, void* d_out, int out_size, void* d_ws, size_t ws_size, hipStream_t stream) {
    static int grid = 0;
    if (grid == 0) {
        if (n_in != 17 || out_size != TOK * DM || ws_size < WS_END) { fprintf(stderr, "kernel_launch: unexpected shapes (n_in %d out %d ws %zu need %zu)\n", n_in, out_size, ws_size, (size_t)WS_END); grid = -1; return; }
        int dev = 0, cus = 0, per_cu = 0;
        hipGetDevice(&dev); hipDeviceGetAttribute(&cus, hipDeviceAttributeMultiprocessorCount, dev);
        hipFuncSetAttribute((const void*)mega<true>, hipFuncAttributeMaxDynamicSharedMemorySize, LDS_BYTES);
#if MK_MULTI
        hipFuncSetAttribute((const void*)mega<false>, hipFuncAttributeMaxDynamicSharedMemorySize, LDS_BYTES);
#endif
        hipOccupancyMaxActiveBlocksPerMultiprocessor(&per_cu, (const void*)mega<true>, 512, LDS_BYTES);
        if (per_cu < 1) { fprintf(stderr, "kernel_launch: occupancy query says %d blocks/CU\n", per_cu); per_cu = 1; }
        (void)hipGetLastError();
        grid = cus;
    }
    if (grid < 0) return;
    Params P{};
    P.x = (const float*)d_in[0]; P.p = (const float*)d_in[1]; P.ln_in_g = (const float*)d_in[2]; P.ln_in_b = (const float*)d_in[3]; P.w_in = (const float*)d_in[4];
    P.lb_logits = (const float*)d_in[5]; P.hg_norm_g = (const float*)d_in[6]; P.w_merge = (const float*)d_in[7]; P.b_merge = (const float*)d_in[8];
    P.w_br_hg = (const float*)d_in[9]; P.w_br_sb = (const float*)d_in[10]; P.w_out = (const float*)d_in[11]; P.w_pe = (const float*)d_in[12];
    P.w_pg = (const float*)d_in[13]; P.b_pg = (const float*)d_in[14]; P.ln_g = (const float*)d_in[15]; P.ln_b = (const float*)d_in[16];
    P.out = (float*)d_out; P.ws = (unsigned char*)d_ws;
#if MK_MULTI
    for (int ph = 0; ph < NPHASES; ++ph) { P.ph_lo = ph; P.ph_hi = ph + 1; hipLaunchKernelGGL(mega<false>, dim3(grid), dim3(512), LDS_BYTES, stream, P); }
#else
    P.ph_lo = 0; P.ph_hi = NPHASES;
    if (hipMemsetAsync((char*)d_ws + WS_BAR, 0, XCD_BAR_WORDS * sizeof(unsigned), stream) != hipSuccess) { fprintf(stderr, "kernel_launch: memset of the barrier words failed\n"); return; }
    void* args[] = {&P};
    hipError_t e = hipLaunchCooperativeKernel((const void*)mega<true>, dim3(grid), dim3(512), args, LDS_BYTES, stream);
    if (e != hipSuccess) fprintf(stderr, "cooperative launch failed: %s (grid %d)\n", hipGetErrorString(e), grid);
#endif
}
```

```cpp
#include <hip/hip_runtime.h>
#include <hip/hip_cooperative_groups.h>
#include <cstdio>
namespace cg = cooperative_groups;

#ifndef MK_MULTI
#define MK_MULTI 0
#endif

#define LAS __attribute__((address_space(3)))
typedef unsigned short bf16_t;
typedef short bf16x8 __attribute__((ext_vector_type(8)));
typedef float f32x2 __attribute__((ext_vector_type(2)));
typedef float f32x4 __attribute__((ext_vector_type(4)));
typedef float f32x16 __attribute__((ext_vector_type(16)));
typedef unsigned u32x4 __attribute__((ext_vector_type(4)));
typedef unsigned u32x2 __attribute__((ext_vector_type(2)));
typedef __bf16 bf2_t __attribute__((ext_vector_type(2)));

constexpr int TOK = 32768, DM = 2048, SEQ_T = 16384;
constexpr float LN_EPS = 1e-5f;
constexpr float DN_ALPHA = 1.189207115002721f;

constexpr size_t WS_WTMAIN = 0;
constexpr size_t WS_WTVT   = WS_WTMAIN + (size_t)9216 * 2048 * 2;
constexpr size_t WS_WMT    = WS_WTVT + (size_t)3072 * 2048 * 2;
constexpr size_t WS_WAT    = WS_WMT + (size_t)4096 * 2048 * 2;
constexpr size_t WS_WBT    = WS_WAT + (size_t)2048 * 2048 * 2;
constexpr size_t WS_WOT    = WS_WBT + (size_t)2048 * 1024 * 2;
constexpr size_t WS_WPGT   = WS_WOT + (size_t)2048 * 2048 * 2;
constexpr size_t WS_WPET   = WS_WPGT + (size_t)2048 * 2048 * 2;
constexpr size_t WS_H      = WS_WPET + (size_t)2048 * 256 * 2;
constexpr size_t WS_QD     = WS_H + (size_t)TOK * 2048 * 2;
constexpr size_t WS_HG     = WS_QD + (size_t)TOK * 2048 * 2;
constexpr size_t WS_VT     = WS_HG + (size_t)TOK * 2048 * 2;
constexpr size_t WS_SQ     = WS_VT + (size_t)3072 * TOK * 2;
constexpr size_t WS_SK     = WS_SQ + (size_t)TOK * 1024 * 2;
constexpr size_t WS_SG     = WS_SK + (size_t)TOK * 1024 * 2;
constexpr size_t WS_PB     = WS_SG + (size_t)TOK * 1024 * 2;
constexpr size_t WS_DEC    = WS_PB + (size_t)TOK * 256 * 2;
constexpr size_t WS_STATS  = WS_DEC + (size_t)512 * 2048 * 4;
constexpr size_t WS_YB     = WS_SG;
constexpr size_t WS_GA     = WS_STATS + (size_t)TOK * 2 * 4;
constexpr size_t WS_GB     = WS_GA + (size_t)TOK * 2048;
constexpr size_t WS_BAR    = WS_GB + (size_t)TOK * 2048;
constexpr size_t WS_END    = WS_BAR + 16384;

struct Params {
    const float *x, *p, *ln_in_g, *ln_in_b, *w_in, *lb_logits, *hg_norm_g, *w_merge, *b_merge, *w_br_hg, *w_br_sb, *w_out, *w_pe, *w_pg, *b_pg, *ln_g, *ln_b;
    float* out; unsigned char* ws;
    int ph_lo, ph_hi;
};

__device__ __forceinline__ unsigned pk2(float lo, float hi) { f32x2 v = {lo, hi}; bf2_t b = __builtin_convertvector(v, bf2_t); return __builtin_bit_cast(unsigned, b); }
__device__ __forceinline__ float bf_lo(unsigned u) { return __uint_as_float(u << 16); }
__device__ __forceinline__ float bf_hi(unsigned u) { return __uint_as_float(u & 0xffff0000u); }
__device__ __forceinline__ float fast_exp(float x) { return __builtin_amdgcn_exp2f(x * 1.4426950408889634f); }
__device__ __forceinline__ float fast_log(float x) { return __builtin_amdgcn_logf(x) * 0.6931471805599453f; }
__device__ __forceinline__ float fast_rcp(float x) { return __builtin_amdgcn_rcpf(x); }
__device__ __forceinline__ float sigmoidf_(float x) { return fast_rcp(1.f + fast_exp(-x)); }
__device__ __forceinline__ float lane_read(float v, int src_lane) { return __int_as_float(__builtin_amdgcn_ds_bpermute(src_lane << 2, __float_as_int(v))); }
__device__ __forceinline__ float wave_sum(float v, int lane) {
#pragma unroll
    for (int o = 1; o < 64; o <<= 1) v += lane_read(v, lane ^ o);
    return v;
}
__device__ __forceinline__ int tid_opaque() { int t = threadIdx.x; asm volatile("" : "+v"(t)); return t; }
#define MFMA32(a, b, c) __builtin_amdgcn_mfma_f32_32x32x16_bf16((a), (b), (c), 0, 0, 0)
__device__ __forceinline__ int crow(int reg, int h) { return (reg & 3) + 8 * (reg >> 2) + 4 * h; }

namespace pg8 {
constexpr int BM = 256, BK = 64, HALF = 128, HTB = HALF * BK * 2, STAGE_BYTES = 8 * HTB, NXCD = 8, WGM = 8;
__device__ __forceinline__ int lds_byte(int r, int c) { const int st = (r >> 4) * 2 + (c >> 5), rr = r & 15, cc = c & 31, ob = rr * 64 + cc * 2; return st * 1024 + (ob ^ (((ob >> 9) & 1) << 5)); }
__device__ __forceinline__ void stage_rc(int b, int& R, int& C) { const int st = b / 1024, sb = b % 1024, swz = sb ^ (((sb >> 9) & 1) << 5); R = (st >> 1) * 16 + swz / 64; C = (st & 1) * 32 + (swz % 64) / 2; }
__device__ __forceinline__ int perm32(int rho) { const int n = rho >> 4, i = rho & 15; return 8 * (i >> 2) + 4 * n + (i & 3); }
struct Unit { int pm, pn; };
struct Gemm { const bf16_t* A; const bf16_t* Bt; int M, N, K; };
struct StaticOrder {
    int nM, nN, nwg, G, c;
    __device__ void init(int M, int N, int G_, int c_) { nM = M / BM; nN = N / BM; nwg = nM * nN; G = G_; c = c_; }
    __device__ bool next(int i, Unit& u) const {
        const long L = (long)i * G + c; if (L >= nwg) return false;
        int wgid = (int)L; { const int q = nwg / NXCD, r = nwg % NXCD, xcd = wgid % NXCD, off = wgid / NXCD; wgid = (xcd < r ? xcd * (q + 1) : r * (q + 1) + (xcd - r) * q) + off; }
        const int nig = WGM * nN, gid = wgid / nig, fm = gid * WGM, gsz = (nM - fm) < WGM ? (nM - fm) : WGM;
        u.pm = fm + ((wgid % nig) % gsz); u.pn = (wgid % nig) / gsz; return true;
    }
};
template <class Epi>
__device__ __forceinline__ void gemm_phase(LAS unsigned char* lds, const Gemm g, const StaticOrder& S, const Epi& E) {
    const int K = g.K, nt = K / BK;
    int wr, wc, fr, fq, aoff, boff; unsigned voffA[2], voffB[2], ldsw;
#define PG8_SETUP() do { const int tid = tid_opaque(), wid = __builtin_amdgcn_readfirstlane(tid >> 6), lane = tid & 63; wr = wid >> 2; wc = wid & 3; fr = lane & 15; fq = lane >> 4; \
        _Pragma("unroll") for (int i = 0; i < 2; ++i) { int R, C; stage_rc(tid * 16 + i * 8192, R, C); const int Rb = (R & ~31) + perm32(R & 31); \
            voffA[i] = (unsigned)(R * K + C) * 2u; voffB[i] = (unsigned)(Rb * K + C) * 2u; } \
        ldsw = (unsigned)wid * 1024u; aoff = lds_byte(wr * 64 + fr, fq * 8); boff = lds_byte(wc * 32 + fr, fq * 8); } while (0)
    PG8_SETUP();
    const size_t kstep = (size_t)(BK * 2);
    const size_t hstep = (size_t)HALF * K * 2;
    const size_t tstep = 2 * hstep;
#define PG8_SA(b, h) (((b) * 2 + (h)) * HTB)
#define PG8_SB(b, h) ((4 + (b) * 2 + (h)) * HTB)
#define PG8_STAGE(bufoff, gbase, voff) do { _Pragma("unroll") for (int _i = 0; _i < 2; ++_i) \
        __builtin_amdgcn_global_load_lds((const unsigned*)((const char*)(gbase) + (voff)[_i]), (LAS unsigned*)(lds + (bufoff) + ldsw + _i * 8192), 16, 0, 0); } while (0)
#define PG8_LDA(dst, b, h) do { _Pragma("unroll") for (int m = 0; m < 4; ++m) _Pragma("unroll") for (int k = 0; k < 2; ++k) dst[m][k] = *(const LAS bf16x8*)(lds + PG8_SA(b, h) + aoff + m * 2048 + k * 1024); } while (0)
#define PG8_LDB(dst, b, h) do { _Pragma("unroll") for (int n = 0; n < 2; ++n) _Pragma("unroll") for (int k = 0; k < 2; ++k) dst[n][k] = *(const LAS bf16x8*)(lds + PG8_SB(b, h) + boff + n * 2048 + k * 1024); } while (0)
#define PG8_MMA(ai, bj, At, Bt) do { __builtin_amdgcn_s_setprio(1); _Pragma("unroll") for (int m = 0; m < 4; ++m) _Pragma("unroll") for (int n = 0; n < 2; ++n) _Pragma("unroll") for (int k = 0; k < 2; ++k) \
        acc[ai][bj][m][n] = __builtin_amdgcn_mfma_f32_16x16x32_bf16(Bt[n][k], At[m][k], acc[ai][bj][m][n], 0, 0, 0); __builtin_amdgcn_s_setprio(0); } while (0)
#define PG8_WAIT_V(n) asm volatile("s_waitcnt vmcnt(" #n ")" ::: "memory")
#define PG8_WAIT_L(n) asm volatile("s_waitcnt lgkmcnt(" #n ")" ::: "memory")
#define PG8_BAR __builtin_amdgcn_s_barrier()
#define PG8_SCHED __builtin_amdgcn_sched_barrier(0)
    Unit cur, nxt; int ui = 0;
    if (!S.next(0, cur)) return;
    f32x4 acc[2][2][4][2];
#pragma unroll
    for (int a = 0; a < 2; ++a)
#pragma unroll
        for (int b = 0; b < 2; ++b)
#pragma unroll
            for (int m = 0; m < 4; ++m)
#pragma unroll
                for (int n = 0; n < 2; ++n) acc[a][b][m][n] = (f32x4){0.f, 0.f, 0.f, 0.f};
    bf16x8 At[4][2], B0[2][2], B1[2][2];
    const char* cA = (const char*)g.A + (size_t)cur.pm * tstep; const char* cB = (const char*)g.Bt + (size_t)cur.pn * tstep;
    PG8_WAIT_V(0);
    PG8_STAGE(PG8_SB(0, 0), cB, voffB); PG8_STAGE(PG8_SA(0, 0), cA, voffA); PG8_STAGE(PG8_SB(0, 1), cB + hstep, voffB); PG8_STAGE(PG8_SA(0, 1), cA + hstep, voffA);
    if (wr == 1) PG8_BAR;
    PG8_WAIT_V(4); PG8_BAR;
    PG8_STAGE(PG8_SB(1, 0), cB + kstep, voffB); PG8_STAGE(PG8_SA(1, 0), cA + kstep, voffA); PG8_STAGE(PG8_SB(1, 1), cB + hstep + kstep, voffB);
    PG8_WAIT_V(6); PG8_BAR;
    for (;;) {
        const bool has_next = S.next(ui + 1, nxt);
        const char* nA = has_next ? (const char*)g.A + (size_t)nxt.pm * tstep : cA; const char* nB = has_next ? (const char*)g.Bt + (size_t)nxt.pn * tstep : cB;
        for (int t = 0; t < nt; t += 2) {
            const bool last = (t == nt - 2);
            const char* a1 = cA + (size_t)(t + 1) * kstep;
            const char* a2 = last ? nA : cA + (size_t)(t + 2) * kstep; const char* b2 = last ? nB : cB + (size_t)(t + 2) * kstep;
            const char* a3 = a2 + kstep; const char* b3 = b2 + kstep;
            PG8_LDB(B0, 0, 0); PG8_SCHED; PG8_LDA(At, 0, 0); PG8_STAGE(PG8_SA(1, 1), a1 + hstep, voffA);
            PG8_WAIT_L(8); PG8_BAR; PG8_WAIT_L(0); PG8_MMA(0, 0, At, B0); PG8_BAR; PG8_SCHED;
            PG8_LDB(B1, 0, 1); PG8_STAGE(PG8_SB(0, 0), b2, voffB);
            PG8_BAR; PG8_WAIT_L(0); PG8_MMA(0, 1, At, B1); PG8_BAR;
            PG8_LDA(At, 0, 1); PG8_STAGE(PG8_SA(0, 0), a2, voffA);
            PG8_BAR; PG8_WAIT_L(0); PG8_MMA(1, 0, At, B0); PG8_BAR; PG8_SCHED;
            PG8_STAGE(PG8_SB(0, 1), b2 + hstep, voffB);
            PG8_WAIT_V(6); PG8_BAR; PG8_MMA(1, 1, At, B1); PG8_BAR;
            PG8_LDB(B0, 1, 0); PG8_SCHED; PG8_LDA(At, 1, 0); PG8_STAGE(PG8_SA(0, 1), a2 + hstep, voffA);
            PG8_WAIT_L(8); PG8_BAR; PG8_WAIT_L(0); PG8_MMA(0, 0, At, B0); PG8_BAR; PG8_SCHED;
            PG8_LDB(B1, 1, 1); PG8_STAGE(PG8_SB(1, 0), b3, voffB);
            PG8_BAR; PG8_WAIT_L(0); PG8_MMA(0, 1, At, B1); PG8_BAR;
            PG8_LDA(At, 1, 1); PG8_STAGE(PG8_SA(1, 0), a3, voffA);
            PG8_BAR; PG8_WAIT_L(0); PG8_MMA(1, 0, At, B0); PG8_BAR; PG8_SCHED;
            PG8_STAGE(PG8_SB(1, 1), b3 + hstep, voffB);
            PG8_WAIT_V(6); PG8_BAR; PG8_MMA(1, 1, At, B1); PG8_BAR;
        }
        E(acc, cur, wr, wc, fr, fq);
        PG8_WAIT_V(0);
        if (!has_next) break;
#pragma unroll
        for (int a = 0; a < 2; ++a)
#pragma unroll
            for (int b = 0; b < 2; ++b)
#pragma unroll
                for (int m = 0; m < 4; ++m)
#pragma unroll
                    for (int n = 0; n < 2; ++n) acc[a][b][m][n] = (f32x4){0.f, 0.f, 0.f, 0.f};
        cur = nxt; cA = nA; cB = nB; ++ui;
        PG8_SETUP();
    }
    PG8_WAIT_V(0);
    if (wr == 0) PG8_BAR;
    PG8_BAR;
#undef PG8_SETUP
#undef PG8_SA
#undef PG8_SB
#undef PG8_STAGE
#undef PG8_LDA
#undef PG8_LDB
#undef PG8_MMA
#undef PG8_WAIT_V
#undef PG8_WAIT_L
#undef PG8_BAR
#undef PG8_SCHED
}
}
using pg8::Unit;
typedef const f32x4 (&AccRef)[2][2][4][2];

__device__ __forceinline__ u32x4 pack8(f32x4 a, f32x4 b) { u32x4 w; w.x = pk2(a[0], a[1]); w.y = pk2(a[2], a[3]); w.z = pk2(b[0], b[1]); w.w = pk2(b[2], b[3]); return w; }
__device__ __forceinline__ void unpack8(u32x4 w, f32x4& a, f32x4& b) { a[0] = bf_lo(w.x); a[1] = bf_hi(w.x); a[2] = bf_lo(w.y); a[3] = bf_hi(w.y); b[0] = bf_lo(w.z); b[1] = bf_hi(w.z); b[2] = bf_lo(w.w); b[3] = bf_hi(w.w); }

__device__ __forceinline__ void store_plain(AccRef acc, bf16_t* dst, size_t ld, int rowt, int colt, int wr, int wc, int fr, int fq) {
    const int row0 = rowt * 256 + wr * 64 + fr, col0 = colt * 256 + wc * 32 + 8 * fq;
#pragma unroll
    for (int ai = 0; ai < 2; ++ai)
#pragma unroll
        for (int m = 0; m < 4; ++m) { bf16_t* rowp = dst + (size_t)(row0 + ai * 128 + m * 16) * ld + col0;
#pragma unroll
            for (int bj = 0; bj < 2; ++bj) *(u32x4*)(rowp + bj * 128) = pack8(acc[ai][bj][m][0], acc[ai][bj][m][1]); __builtin_amdgcn_sched_barrier(0); }
}

template <int CTRL> __device__ __forceinline__ float dpp_mov0(float x) { return __int_as_float(__builtin_amdgcn_update_dpp(0, __float_as_int(x), CTRL, 0xf, 0xf, true)); }
__device__ __forceinline__ float scan16(float x) { x += dpp_mov0<0x111>(x); x += dpp_mov0<0x112>(x); x += dpp_mov0<0x114>(x); x += dpp_mov0<0x118>(x); return x; }

struct EpiProj {
    static constexpr bool PERM = true;
    bf16_t *QD, *KI, *KET, *HG, *SQ, *SK, *SG; float* DEC; const float* lbl;
    __device__ __forceinline__ void operator()(AccRef acc, const Unit& u, int wr, int wc, int fr, int fq) const {
        if (u.pn >= 16) {
            if (u.pn < 24) store_plain(acc, HG, 2048, u.pm, u.pn - 16, wr, wc, fr, fq);
            else if (u.pn < 28) store_plain(acc, SQ, 1024, u.pm, u.pn - 24, wr, wc, fr, fq);
            else if (u.pn < 32) store_plain(acc, SK, 1024, u.pm, u.pn - 28, wr, wc, fr, fq);
            else store_plain(acc, SG, 1024, u.pm, u.pn - 32, wr, wc, fr, fq);
            return;
        }
        const int head = u.pn, kk0 = wc * 32 + 8 * fq, hc0 = head * 128 + kk0;
        const int lane = fr + 16 * fq;
        float lbreg; { const int cc = head * 128 + wc * 32 + (lane & 31); const float l0 = lbl[cc], l1 = lbl[2048 + cc]; lbreg = fast_rcp(1.f + fast_exp(l1 - l0)); }
#pragma unroll
        for (int ai = 0; ai < 2; ++ai) {
            const int rowb = u.pm * 256 + ai * 128 + wr * 64, row0 = rowb + fr, chunk = rowb >> 6;
            unsigned qdp[4][4], kip[4][4];
#pragma unroll
            for (int n = 0; n < 2; ++n) {
#pragma unroll
                for (int jp = 0; jp < 2; ++jp) {
                    float qd2[4], ki2[4], dec2;
#pragma unroll
                    for (int e = 0; e < 2; ++e) {
                        const int j = 2 * jp + e, c = 4 * n + j;
                        const float lb = lane_read(lbreg, 8 * fq + c);
                        float lf[4], kv[4];
#pragma unroll
                        for (int m = 0; m < 4; ++m) { const float xx = acc[ai][1][m][n][j]; const float f = lb + (1.f - lb) * sigmoidf_(xx); kv[m] = 1.f - f; lf[m] = scan16(fast_log(f)); }
                        const int src = lane | 15;
                        const float t0 = lane_read(lf[0], src), t1 = lane_read(lf[1], src), t2 = lane_read(lf[2], src), t3 = lane_read(lf[3], src);
                        float bc[4]; bc[0] = lf[0]; bc[1] = lf[1] + t0; bc[2] = lf[2] + (t0 + t1); bc[3] = lf[3] + (t0 + t1 + t2);
                        const float dec = fast_exp(t0 + t1 + t2 + t3);
#pragma unroll
                        for (int m = 0; m < 4; ++m) { const float ee = fast_exp(bc[m]); const float qd = acc[ai][0][m][n][j] * ee; const float ki = kv[m] * fast_rcp(ee);
                            const float ke = ki * dec; KET[(unsigned)((chunk * 2048 + hc0 + c) * 64 + fr + 16 * m)] = (bf16_t)(pk2(ke, 0.f) & 0xffffu);
                            if (e == 0) { qd2[m] = qd; ki2[m] = ki; }
                            else { qdp[m][2 * n + jp] = pk2(qd2[m], qd); kip[m][2 * n + jp] = pk2(ki2[m], ki); } }
                        if (e == 0) dec2 = dec;
                        else if (fr == 0) { float* dp = DEC + (unsigned)(chunk * 2048 + hc0 + 4 * n + 2 * jp); *(f32x2*)dp = (f32x2){dec2, dec}; }
                        __builtin_amdgcn_sched_barrier(0);
                    }
                }
            }
#pragma unroll
            for (int m = 0; m < 4; ++m) { const unsigned o = (unsigned)((row0 + 16 * m) * 2048 + hc0);
                u32x4 qa; qa.x = qdp[m][0]; qa.y = qdp[m][1]; qa.z = qdp[m][2]; qa.w = qdp[m][3]; *(u32x4*)(QD + o) = qa;
                u32x4 kb_; kb_.x = kip[m][0]; kb_.y = kip[m][1]; kb_.z = kip[m][2]; kb_.w = kip[m][3]; *(u32x4*)(KI + o) = kb_; }
        }
    }
};
struct EpiPlain {
    static constexpr bool PERM = true;
    bf16_t* dst; int ld;
    __device__ __forceinline__ void operator()(AccRef acc, const Unit& u, int wr, int wc, int fr, int fq) const { store_plain(acc, dst, (size_t)ld, u.pm, u.pn, wr, wc, fr, fq); }
};
struct EpiVT {
    static constexpr bool PERM = true;
    bf16_t* dst;
    __device__ __forceinline__ void operator()(AccRef acc, const Unit& u, int wr, int wc, int fr, int fq) const {
        const int row0 = u.pm * 256 + wr * 64 + fr, col0 = u.pn * 256 + wc * 32 + 8 * fq;
#pragma unroll
        for (int ai = 0; ai < 2; ++ai)
#pragma unroll
            for (int m = 0; m < 4; ++m)
#pragma unroll
                for (int bj = 0; bj < 2; ++bj) { const int row = row0 + ai * 128 + m * 16, col = col0 + bj * 128;
                    *(u32x4*)(dst + ((size_t)((col >> 6) * 3072 + row) * 64 + (col & 63))) = pack8(acc[ai][bj][m][0], acc[ai][bj][m][1]); __builtin_amdgcn_sched_barrier(0); }
    }
};
__device__ __forceinline__ unsigned q8(float g) { return (unsigned)(g * 255.f + 0.5f); }
__device__ __forceinline__ u32x2 pack8u(f32x4 a, f32x4 b) { u32x2 w; w.x = q8(a[0]) | (q8(a[1]) << 8) | (q8(a[2]) << 16) | (q8(a[3]) << 24); w.y = q8(b[0]) | (q8(b[1]) << 8) | (q8(b[2]) << 16) | (q8(b[3]) << 24); return w; }
__device__ __forceinline__ void unpack8u(u32x2 w, f32x4& a, f32x4& b) { const float k = 1.f / 255.f;
    a[0] = (float)(w.x & 255u) * k; a[1] = (float)((w.x >> 8) & 255u) * k; a[2] = (float)((w.x >> 16) & 255u) * k; a[3] = (float)(w.x >> 24) * k;
    b[0] = (float)(w.y & 255u) * k; b[1] = (float)((w.y >> 8) & 255u) * k; b[2] = (float)((w.y >> 16) & 255u) * k; b[3] = (float)(w.y >> 24) * k; }
struct EpiGate {
    static constexpr bool PERM = true;
    unsigned char *ga, *gb; const float* bias;
    __device__ __forceinline__ void operator()(AccRef acc, const Unit& u, int wr, int wc, int fr, int fq) const {
        unsigned char* dst = u.pn < 8 ? ga : gb;
        const int row0 = u.pm * 256 + wr * 64 + fr, col0 = (u.pn & 7) * 256 + wc * 32 + 8 * fq, bcol0 = u.pn * 256 + wc * 32 + 8 * fq;
#pragma unroll
        for (int bj = 0; bj < 2; ++bj) { const f32x4 b0 = *(const f32x4*)(bias + bcol0 + bj * 128), b1 = *(const f32x4*)(bias + bcol0 + bj * 128 + 4);
#pragma unroll
            for (int ai = 0; ai < 2; ++ai)
#pragma unroll
                for (int m = 0; m < 4; ++m) { f32x4 v0 = acc[ai][bj][m][0] + b0, v1 = acc[ai][bj][m][1] + b1;
#pragma unroll
                    for (int j = 0; j < 4; ++j) { v0[j] = sigmoidf_(v0[j]); v1[j] = sigmoidf_(v1[j]); }
                    *(u32x2*)(dst + (size_t)(row0 + ai * 128 + m * 16) * 2048 + col0 + bj * 128) = pack8u(v0, v1); __builtin_amdgcn_sched_barrier(0); } }
    }
};
struct EpiMul {
    static constexpr bool PERM = true;
    bf16_t* m1; const unsigned char* G;
    __device__ __forceinline__ void operator()(AccRef acc, const Unit& u, int wr, int wc, int fr, int fq) const {
        const int row0 = u.pm * 256 + wr * 64 + fr, col0 = u.pn * 256 + wc * 32 + 8 * fq;
#pragma unroll
        for (int ai = 0; ai < 2; ++ai)
#pragma unroll
            for (int m = 0; m < 4; ++m)
#pragma unroll
                for (int bj = 0; bj < 2; ++bj) { const size_t o = (size_t)(row0 + ai * 128 + m * 16) * 2048 + col0 + bj * 128;
                    f32x4 g0, g1; unpack8u(*(const u32x2*)(G + o), g0, g1);
                    *(u32x4*)(m1 + o) = pack8(acc[ai][bj][m][0] * g0, acc[ai][bj][m][1] * g1); __builtin_amdgcn_sched_barrier(0); }
    }
};
struct EpiMulAdd {
    static constexpr bool PERM = true;
    bf16_t* mo; const bf16_t* m1; const unsigned char* G;
    __device__ __forceinline__ void operator()(AccRef acc, const Unit& u, int wr, int wc, int fr, int fq) const {
        const int row0 = u.pm * 256 + wr * 64 + fr, col0 = u.pn * 256 + wc * 32 + 8 * fq;
#pragma unroll
        for (int ai = 0; ai < 2; ++ai)
#pragma unroll
            for (int m = 0; m < 4; ++m)
#pragma unroll
                for (int bj = 0; bj < 2; ++bj) { const size_t o = (size_t)(row0 + ai * 128 + m * 16) * 2048 + col0 + bj * 128;
                    f32x4 g0, g1; unpack8u(*(const u32x2*)(G + o), g0, g1);
                    f32x4 a0, a1; unpack8(*(const u32x4*)(m1 + o), a0, a1);
                    *(u32x4*)(mo + o) = pack8(a0 + acc[ai][bj][m][0] * g0, a1 + acc[ai][bj][m][1] * g1); __builtin_amdgcn_sched_barrier(0); }
    }
};
struct EpiOut {
    static constexpr bool PERM = true;
    float* r; bf16_t* rb; const float *x, *stats, *g, *b;
    __device__ __forceinline__ void operator()(AccRef acc, const Unit& u, int wr, int wc, int fr, int fq) const {
        const int row0 = u.pm * 256 + wr * 64 + fr, col0 = u.pn * 256 + wc * 32 + 8 * fq;
#pragma unroll
        for (int bj = 0; bj < 2; ++bj) { const int c = col0 + bj * 128;
            const f32x4 g0 = *(const f32x4*)(g + c), g1 = *(const f32x4*)(g + c + 4), b0 = *(const f32x4*)(b + c), b1 = *(const f32x4*)(b + c + 4);
            f32x4 nx0, nx1; float nmean, nrstd;
            { const int row = row0; const size_t o = (size_t)row * 2048 + c; nmean = stats[2 * row]; nrstd = stats[2 * row + 1]; nx0 = *(const f32x4*)(x + o); nx1 = *(const f32x4*)(x + o + 4); }
#pragma unroll
            for (int it = 0; it < 8; ++it) { const int ai = it >> 2, m = it & 3;
                const int row = row0 + ai * 128 + m * 16; const size_t o = (size_t)row * 2048 + c;
                const f32x4 x0 = nx0, x1 = nx1; const float mean = nmean, rstd = nrstd;
                if (it + 1 < 8) { const int ai2 = (it + 1) >> 2, m2 = (it + 1) & 3; const int row2 = row0 + ai2 * 128 + m2 * 16; const size_t o2 = (size_t)row2 * 2048 + c;
                    nmean = stats[2 * row2]; nrstd = stats[2 * row2 + 1]; nx0 = *(const f32x4*)(x + o2); nx1 = *(const f32x4*)(x + o2 + 4); }
                __builtin_amdgcn_sched_barrier(0);
                const f32x4 r0 = ((x0 - mean) * rstd * g0 + b0) * DN_ALPHA + acc[ai][bj][m][0], r1 = ((x1 - mean) * rstd * g1 + b1) * DN_ALPHA + acc[ai][bj][m][1];
                *(f32x4*)(r + o) = r0; *(f32x4*)(r + o + 4) = r1; *(u32x4*)(rb + o) = pack8(r0, r1); __builtin_amdgcn_sched_barrier(0); } }
    }
};
struct EpiFinal {
    static constexpr bool PERM = true;
    float* r; const bf16_t* pe; const float* bias;
    __device__ __forceinline__ void operator()(AccRef acc, const Unit& u, int wr, int wc, int fr, int fq) const {
        const int row0 = u.pm * 256 + wr * 64 + fr, col0 = u.pn * 256 + wc * 32 + 8 * fq;
#pragma unroll
        for (int bj = 0; bj < 2; ++bj) { const int c = col0 + bj * 128;
            const f32x4 b0 = *(const f32x4*)(bias + c), b1 = *(const f32x4*)(bias + c + 4);
#pragma unroll
            for (int ai = 0; ai < 2; ++ai)
#pragma unroll
                for (int m = 0; m < 4; ++m) { const size_t o = (size_t)(row0 + ai * 128 + m * 16) * 2048 + c;
                    f32x4 p0, p1; unpack8(*(const u32x4*)(pe + o), p0, p1);
                    f32x4 v0 = acc[ai][bj][m][0] + b0, v1 = acc[ai][bj][m][1] + b1;
#pragma unroll
                    for (int j = 0; j < 4; ++j) { v0[j] = sigmoidf_(v0[j]); v1[j] = sigmoidf_(v1[j]); }
                    const f32x4 r0 = *(const f32x4*)(r + o) + v0 * p0, r1 = *(const f32x4*)(r + o + 4) + v1 * p1;
                    *(f32x4*)(r + o) = r0; *(f32x4*)(r + o + 4) = r1; __builtin_amdgcn_sched_barrier(0); } }
    }
};

__device__ __forceinline__ int win_srccol(int vr) {
    if (vr < 4096) { const int pn = vr >> 8, rr = vr & 255; return rr < 128 ? pn * 128 + rr : 2048 + pn * 128 + (rr - 128); }
    if (vr < 6144) return 6144 + (vr - 4096);
    if (vr < 7168) return 8192 + (vr - 6144);
    if (vr < 8192) return 9216 + (vr - 7168);
    if (vr < 9216) return 11264 + (vr - 8192);
    if (vr < 11264) return 4096 + (vr - 9216);
    return 10240 + (vr - 11264);
}
__device__ __forceinline__ void transpose_item(const float* W, int K, int N, bf16_t* WT, int k0, int scol0, int drow0, LAS float* scr, int lane) {
#pragma unroll 8
    for (int i = 0; i < 32; ++i) { const int kk = 2 * i + (lane >> 5); scr[kk * 33 + (lane & 31)] = W[(size_t)(k0 + kk) * N + scol0 + (lane & 31)]; }
    __builtin_amdgcn_s_waitcnt(0xc07f); asm volatile("" ::: "memory");
    const int c = lane & 7;
#pragma unroll
    for (int j = 0; j < 4; ++j) { const int n = (lane >> 3) + 8 * j; const LAS float* s = scr + (8 * c) * 33 + n;
        u32x4 o; o.x = pk2(s[0 * 33], s[1 * 33]); o.y = pk2(s[2 * 33], s[3 * 33]); o.z = pk2(s[4 * 33], s[5 * 33]); o.w = pk2(s[6 * 33], s[7 * 33]);
        *(u32x4*)(WT + (size_t)(drow0 + n) * K + k0 + 8 * c) = o; }
    __builtin_amdgcn_s_waitcnt(0xc07f); asm volatile("" ::: "memory");
}
__device__ __forceinline__ void phase0(const Params& P, LAS unsigned char* lds) {
    const int tid = tid_opaque(), wave = tid >> 6, lane = tid & 63;
    const int gw = blockIdx.x * 8 + wave, NGW = gridDim.x * 8;
    bf16_t* H = (bf16_t*)(P.ws + WS_H); float* stats = (float*)(P.ws + WS_STATS);
    LAS float* scr = (LAS float*)(lds + wave * 16384);
    constexpr int I_IN = 32 * 384, I_M = 32 * 128;
    for (int it = gw; it < I_IN + I_M; it += NGW) {
        int r = it;
        if (r < I_IN) { const int kb = r / 384, nb = r % 384; transpose_item(P.w_in, 2048, 12288, (bf16_t*)(P.ws + WS_WTMAIN), 64 * kb, win_srccol(32 * nb), 32 * nb, scr, lane); continue; } r -= I_IN;
        { const int kb = r / 128, nb = r % 128; transpose_item(P.w_merge, 2048, 4096, (bf16_t*)(P.ws + WS_WMT), 64 * kb, 32 * nb, 32 * nb, scr, lane); }
    }
    for (int row = gw; row < TOK; row += NGW) {
        const f32x4* xr = (const f32x4*)(P.x + (size_t)row * DM) + lane;
        f32x4 v[8]; float s = 0.f;
#pragma unroll
        for (int j = 0; j < 8; ++j) { v[j] = xr[64 * j]; s += (v[j][0] + v[j][1]) + (v[j][2] + v[j][3]); }
        const float mean = wave_sum(s, lane) * (1.f / DM); float s2 = 0.f;
#pragma unroll
        for (int j = 0; j < 8; ++j) { v[j] = v[j] - mean; s2 += (v[j][0] * v[j][0] + v[j][1] * v[j][1]) + (v[j][2] * v[j][2] + v[j][3] * v[j][3]); }
        const float rstd = 1.f / sqrtf(wave_sum(s2, lane) * (1.f / DM) + LN_EPS);
        u32x2* o8 = (u32x2*)(H + (size_t)row * DM) + lane;
#pragma unroll
        for (int j = 0; j < 8; ++j) { const f32x4 g = *((const f32x4*)P.ln_in_g + lane + 64 * j), b = *((const f32x4*)P.ln_in_b + lane + 64 * j);
            const f32x4 y = v[j] * rstd * g + b; u32x2 w; w.x = pk2(y[0], y[1]); w.y = pk2(y[2], y[3]); o8[64 * j] = w; }
        if (lane == 0) { stats[2 * row] = mean; stats[2 * row + 1] = rstd; }
    }
}

__device__ __forceinline__ void late_transposes(const Params& P, LAS unsigned char* lds, int blk0) {
    const int tid = tid_opaque(), wave = tid >> 6, lane = tid & 63;
    const int gw = ((int)blockIdx.x - blk0) * 8 + wave, NGW = ((int)gridDim.x - blk0) * 8;
    LAS float* scr = (LAS float*)(lds + wave * 16384);
    constexpr int I_A = 32 * 64, I_B = 16 * 64, I_O = 32 * 64, I_PG = 32 * 64, I_PE = 4 * 64;
    for (int it = gw; it < I_A + I_B + I_O + I_PG + I_PE; it += NGW) {
        int r = it;
        if (r < I_A) { const int kb = r / 64, nb = r % 64; transpose_item(P.w_br_hg, 2048, 2048, (bf16_t*)(P.ws + WS_WAT), 64 * kb, 32 * nb, 32 * nb, scr, lane); continue; } r -= I_A;
        if (r < I_B) { const int kb = r / 64, nb = r % 64; transpose_item(P.w_br_sb, 1024, 2048, (bf16_t*)(P.ws + WS_WBT), 64 * kb, 32 * nb, 32 * nb, scr, lane); continue; } r -= I_B;
        if (r < I_O) { const int kb = r / 64, nb = r % 64; transpose_item(P.w_out, 2048, 2048, (bf16_t*)(P.ws + WS_WOT), 64 * kb, 32 * nb, 32 * nb, scr, lane); continue; } r -= I_O;
        if (r < I_PG) { const int kb = r / 64, nb = r % 64; transpose_item(P.w_pg, 2048, 2048, (bf16_t*)(P.ws + WS_WPGT), 64 * kb, 32 * nb, 32 * nb, scr, lane); continue; } r -= I_PG;
        { const int kb = r / 64, nb = r % 64; transpose_item(P.w_pe, 256, 2048, (bf16_t*)(P.ws + WS_WPET), 64 * kb, 32 * nb, 32 * nb, scr, lane); }
    }
    { const f32x4* ps = (const f32x4*)P.p; u32x4* pd = (u32x4*)(P.ws + WS_PB);
      for (size_t i = (size_t)((int)blockIdx.x - blk0) * 512 + tid; i < (size_t)TOK * 256 / 8; i += (size_t)((int)gridDim.x - blk0) * 512) { const f32x4 a = ps[2 * i], b = ps[2 * i + 1]; pd[i] = pack8(a, b); } }
    __syncthreads();
}

constexpr int HL_QD = 0, HL_KI = 17408, HL_KET = 34816, HL_VT = 53248, HL_ST = 71680, HL_RED = 106496, HL_HGT = 108032, HL_DEC = 125440, HL_HGT2 = 125952;
#define LDS_BARRIER() do { asm volatile("s_waitcnt lgkmcnt(0)" ::: "memory"); __builtin_amdgcn_s_barrier(); asm volatile("" ::: "memory"); } while (0)
__device__ __forceinline__ void hgrn2_seq(const Params& P, LAS unsigned char* lds, float* outbuf, int item) {
    const int tid = tid_opaque(), w = __builtin_amdgcn_readfirstlane(tid >> 6), lane = tid & 63, r = lane & 31, h = lane >> 5;
    const int tb = w >> 2, vb = w & 3, kb = w >> 1, vb2 = 2 * (w & 1);
    const int b = item >> 4, head = item & 15, hbase = head * 128; const size_t tokbase = (size_t)b * SEQ_T;
    const bf16_t* QD = (const bf16_t*)(P.ws + WS_QD); const bf16_t* KI = (const bf16_t*)outbuf; const bf16_t* KET = (const bf16_t*)outbuf + (size_t)TOK * 2048;
    const bf16_t* VT = (const bf16_t*)(P.ws + WS_VT); bf16_t* HG = (bf16_t*)(P.ws + WS_HG); const float* DEC = (const float*)(P.ws + WS_DEC);
    LAS float* RED = (LAS float*)(lds + HL_RED);
    f32x16 S[2];
#pragma unroll
    for (int q = 0; q < 2; ++q)
#pragma unroll
        for (int i = 0; i < 16; ++i) S[q][i] = 0.f;
    if (tid < 128) ((LAS float*)(lds + HL_RED + 1024))[tid] = P.hg_norm_g[hbase + tid];
    const LAS float* gnp = (const LAS float*)(lds + HL_RED + 1024) + 32 * vb + 4 * h;
    const int idA0 = tid, idA1 = tid + 512;
    const int rA0 = idA0 >> 4, cA0 = idA0 & 15, rA1 = idA1 >> 4, cA1 = idA1 & 15;
    const int rT0 = idA0 >> 3, cT0 = idA0 & 7, rT1 = idA1 >> 3, cT1 = idA1 & 7;
    u32x4 pf[10]; float pfd = 0.f;
#define HG_LOAD_PF(c) do { const size_t t0 = tokbase + 64 * (size_t)(c); \
        pf[0] = *(const u32x4*)(QD + (t0 + rA0) * 2048 + hbase + 8 * cA0); pf[1] = *(const u32x4*)(QD + (t0 + rA1) * 2048 + hbase + 8 * cA1); \
        pf[2] = *(const u32x4*)(KI + (t0 + rA0) * 2048 + hbase + 8 * cA0); pf[3] = *(const u32x4*)(KI + (t0 + rA1) * 2048 + hbase + 8 * cA1); \
        pf[4] = *(const u32x4*)(KET + ((t0 >> 6) * 2048 + hbase + rT0) * 64 + 8 * cT0); pf[5] = *(const u32x4*)(KET + ((t0 >> 6) * 2048 + hbase + rT1) * 64 + 8 * cT1); \
        pf[6] = *(const u32x4*)(VT + ((t0 >> 6) * 3072 + hbase + rT0) * 64 + 8 * cT0); pf[7] = *(const u32x4*)(VT + ((t0 >> 6) * 3072 + hbase + rT1) * 64 + 8 * cT1); \
        pf[8] = *(const u32x4*)(HG + (t0 + rA0) * 2048 + hbase + 8 * cA0); pf[9] = *(const u32x4*)(HG + (t0 + rA1) * 2048 + hbase + 8 * cA1); \
        if (tid < 128) pfd = DEC[(t0 >> 6) * 2048 + hbase + tid]; } while (0)
    HG_LOAD_PF(0);
#pragma unroll 1
    for (int c = 0; c < 256; ++c) {
        *(LAS u32x4*)(lds + HL_QD + rA0 * 272 + cA0 * 16) = pf[0]; *(LAS u32x4*)(lds + HL_QD + rA1 * 272 + cA1 * 16) = pf[1];
        *(LAS u32x4*)(lds + HL_KI + rA0 * 272 + cA0 * 16) = pf[2]; *(LAS u32x4*)(lds + HL_KI + rA1 * 272 + cA1 * 16) = pf[3];
        *(LAS u32x4*)(lds + HL_KET + rT0 * 144 + cT0 * 16) = pf[4]; *(LAS u32x4*)(lds + HL_KET + rT1 * 144 + cT1 * 16) = pf[5];
        *(LAS u32x4*)(lds + HL_VT + rT0 * 144 + cT0 * 16) = pf[6]; *(LAS u32x4*)(lds + HL_VT + rT1 * 144 + cT1 * 16) = pf[7];
        const int hgt_off = (c & 1) ? HL_HGT2 : HL_HGT;
        *(LAS u32x4*)(lds + hgt_off + rA0 * 272 + cA0 * 16) = pf[8]; *(LAS u32x4*)(lds + hgt_off + rA1 * 272 + cA1 * 16) = pf[9];
        if (tid < 128) ((LAS float*)(lds + HL_DEC))[tid] = pfd;
#pragma unroll
        for (int q = 0; q < 2; ++q)
#pragma unroll
            for (int g = 0; g < 4; ++g) { u32x2 v; v.x = pk2(S[q][4 * g], S[q][4 * g + 1]); v.y = pk2(S[q][4 * g + 2], S[q][4 * g + 3]);
                *(LAS u32x2*)(lds + HL_ST + (32 * (vb2 + q) + r) * 272 + (32 * kb + 8 * g + 4 * h) * 2) = v; }
        LDS_BARRIER();
        const size_t tok = tokbase + 64 * (size_t)c + 32 * tb + r;
        bf16_t* hgp = HG + tok * 2048 + hbase + 32 * vb + 4 * h;
        if (c + 1 < 256) HG_LOAD_PF(c + 1);
        bf16x8 qf[8];
#pragma unroll
        for (int st = 0; st < 8; ++st) qf[st] = *(const LAS bf16x8*)(lds + HL_QD + (32 * tb + r) * 272 + (16 * st + 8 * h) * 2);
        f32x16 o;
#pragma unroll
        for (int i = 0; i < 16; ++i) o[i] = 0.f;
#pragma unroll 1
        for (int sb = 0; sb <= tb; ++sb) {
            bf16x8 kf[8];
#pragma unroll
            for (int st = 0; st < 8; ++st) kf[st] = *(const LAS bf16x8*)(lds + HL_KI + (32 * sb + r) * 272 + (16 * st + 8 * h) * 2);
            u32x4 vf[2];
#pragma unroll
            for (int u = 0; u < 2; ++u) { const LAS unsigned char* vp = lds + HL_VT + (32 * vb + r) * 144 + (32 * sb + 16 * u + 4 * h) * 2;
                const u32x2 lo = *(const LAS u32x2*)vp, hi = *(const LAS u32x2*)(vp + 16); vf[u].x = lo.x; vf[u].y = lo.y; vf[u].z = hi.x; vf[u].w = hi.y; }
            __builtin_amdgcn_sched_barrier(0);
            f32x16 a0, a1;
#pragma unroll
            for (int i = 0; i < 16; ++i) { a0[i] = 0.f; a1[i] = 0.f; }
#pragma unroll
            for (int st = 0; st < 4; ++st) { a0 = MFMA32(kf[st], qf[st], a0); a1 = MFMA32(kf[st + 4], qf[st + 4], a1); }
            f32x16 a = a0 + a1;
            if (sb == tb) {
#pragma unroll
                for (int i = 0; i < 16; ++i) a[i] = (crow(i, h) <= r) ? a[i] : 0.f;
            }
#pragma unroll
            for (int u = 0; u < 2; ++u) {
                u32x4 pa; pa.x = pk2(a[8 * u], a[8 * u + 1]); pa.y = pk2(a[8 * u + 2], a[8 * u + 3]); pa.z = pk2(a[8 * u + 4], a[8 * u + 5]); pa.w = pk2(a[8 * u + 6], a[8 * u + 7]);
                o = MFMA32(__builtin_bit_cast(bf16x8, vf[u]), __builtin_bit_cast(bf16x8, pa), o);
            }
        }
        {
            bf16x8 sf[8];
#pragma unroll
            for (int st = 0; st < 8; ++st) sf[st] = *(const LAS bf16x8*)(lds + HL_ST + (32 * vb + r) * 272 + (16 * st + 8 * h) * 2);
            __builtin_amdgcn_sched_barrier(0);
            f32x16 o1;
#pragma unroll
            for (int i = 0; i < 16; ++i) o1[i] = 0.f;
#pragma unroll
            for (int st = 0; st < 4; ++st) { o = MFMA32(sf[st], qf[st], o); o1 = MFMA32(sf[st + 4], qf[st + 4], o1); }
            o = o + o1;
        }
        float ss = 0.f;
#pragma unroll
        for (int i = 0; i < 16; ++i) ss += o[i] * o[i];
        ss += lane_read(ss, lane ^ 32);
        if (h == 0) RED[vb * 64 + 32 * tb + r] = ss;
        {
            bf16x8 kef[4], vf2[2][4];
#pragma unroll
            for (int u = 0; u < 4; ++u) { kef[u] = *(const LAS bf16x8*)(lds + HL_KET + (32 * kb + r) * 144 + (16 * u + 8 * h) * 2);
#pragma unroll
                for (int q = 0; q < 2; ++q) vf2[q][u] = *(const LAS bf16x8*)(lds + HL_VT + (32 * (vb2 + q) + r) * 144 + (16 * u + 8 * h) * 2); }
#pragma unroll
            for (int g = 0; g < 4; ++g) { const f32x4 dvg = *(const LAS f32x4*)(lds + HL_DEC + (32 * kb + 8 * g + 4 * h) * 4);
#pragma unroll
                for (int q = 0; q < 2; ++q)
#pragma unroll
                    for (int e = 0; e < 4; ++e) S[q][4 * g + e] *= dvg[e]; }
            __builtin_amdgcn_sched_barrier(0);
#pragma unroll
            for (int u = 0; u < 4; ++u) { S[0] = MFMA32(kef[u], vf2[0][u], S[0]); S[1] = MFMA32(kef[u], vf2[1][u], S[1]); }
        }
        LDS_BARRIER();
        const float tot = RED[32 * tb + r] + RED[64 + 32 * tb + r] + RED[128 + 32 * tb + r] + RED[192 + 32 * tb + r];
        const float rstd = 1.f / sqrtf(tot * (1.f / 128.f) + LN_EPS);
#pragma unroll
        for (int g = 0; g < 4; ++g) {
            const u32x2 hgvg = *(const LAS u32x2*)(lds + hgt_off + (32 * tb + r) * 272 + (32 * vb + 8 * g + 4 * h) * 2);
            const float g0 = bf_lo(hgvg.x), g1 = bf_hi(hgvg.x), g2 = bf_lo(hgvg.y), g3 = bf_hi(hgvg.y);
            const f32x4 gn = *(const LAS f32x4*)(gnp + 8 * g);
            const float y0 = o[4 * g] * rstd * gn[0] * (g0 * sigmoidf_(g0)), y1 = o[4 * g + 1] * rstd * gn[1] * (g1 * sigmoidf_(g1));
            const float y2 = o[4 * g + 2] * rstd * gn[2] * (g2 * sigmoidf_(g2)), y3 = o[4 * g + 3] * rstd * gn[3] * (g3 * sigmoidf_(g3));
            u32x2 wv; wv.x = pk2(y0, y1); wv.y = pk2(y2, y3); *(u32x2*)(hgp + 8 * g) = wv;
        }
    }
#undef HG_LOAD_PF
}

__device__ __forceinline__ void sb_attention(const Params& P, int blk0) {
    const int tid_ = tid_opaque(); const int gwave = ((int)blockIdx.x - blk0) * 8 + __builtin_amdgcn_readfirstlane(tid_ >> 6), nwaves = ((int)gridDim.x - blk0) * 8;
    const int lane = tid_ & 63, r = lane & 31, h = lane >> 5;
    const bf16_t* SQ = (const bf16_t*)(P.ws + WS_SQ); const bf16_t* SK = (const bf16_t*)(P.ws + WS_SK); const bf16_t* SG = (const bf16_t*)(P.ws + WS_SG);
    const bf16_t* VT = (const bf16_t*)(P.ws + WS_VT);
    const float scale = 0.08838834764831845f;
    for (int item = gwave; item < 8192; item += nwaves) {
        const int qt = item & 511, hd = (item >> 9) & 7, b = item >> 12;
        const size_t tokbase = (size_t)b * SEQ_T;
        const bf16_t* qrow = SQ + (tokbase + 32 * qt + r) * 1024 + hd * 128 + 8 * h;
        bf16x8 qf[8];
#pragma unroll
        for (int st = 0; st < 8; ++st) qf[st] = *(const bf16x8*)(qrow + 16 * st);
        f32x16 o[4];
#pragma unroll
        for (int d = 0; d < 4; ++d)
#pragma unroll
            for (int i = 0; i < 16; ++i) o[d][i] = 0.f;
        float R = 0.f;
        bf16x8 kf[8], kfn[8]; u32x4 vf[4][2];
#define SB_LOAD_K(KF, kt_) do { \
            const bf16_t* krow_ = SK + (tokbase + 32 * (kt_) + r) * 1024 + hd * 128 + 8 * h; \
            _Pragma("unroll") for (int st = 0; st < 8; ++st) KF[st] = *(const bf16x8*)(krow_ + 16 * st); } while (0)
#define SB_LOAD_V(VF, kt_) do { \
            const bf16_t* vbase_ = VT + ((size_t)(b * 256 + ((kt_) >> 1)) * 3072 + 2048 + hd * 128 + r) * 64 + ((kt_) & 1) * 32 + 4 * h; \
            _Pragma("unroll") for (int d = 0; d < 4; ++d) _Pragma("unroll") for (int u = 0; u < 2; ++u) { const bf16_t* vp_ = vbase_ + d * 32 * 64 + 16 * u; \
                const u32x2 lo_ = *(const u32x2*)vp_, hi_ = *(const u32x2*)(vp_ + 8); VF[d][u].x = lo_.x; VF[d][u].y = lo_.y; VF[d][u].z = hi_.x; VF[d][u].w = hi_.y; } } while (0)
        SB_LOAD_K(kf, qt);
#pragma unroll 1
        for (int kt = qt; kt >= 0; --kt) {
            SB_LOAD_V(vf, kt);
            if (kt > 0) SB_LOAD_K(kfn, kt - 1);
            f32x16 s;
#pragma unroll
            for (int i = 0; i < 16; ++i) s[i] = 0.f;
#pragma unroll
            for (int st = 0; st < 8; ++st) s = MFMA32(kf[st], qf[st], s);
            const bool diag = (kt == qt);
            float l[16];
#pragma unroll
            for (int i = 0; i < 16; ++i) { const float z = s[i] * scale; s[i] = z; const float sp = fmaxf(z, 0.f) + fast_log(1.f + fast_exp(-fabsf(z)));
                const bool valid = !diag || (crow(i, h) < r); l[i] = valid ? -sp : 0.f; }
            float G[4], Hs[4], T[4];
#pragma unroll
            for (int g = 0; g < 4; ++g) { G[g] = (l[4 * g] + l[4 * g + 1]) + (l[4 * g + 2] + l[4 * g + 3]); Hs[g] = lane_read(G[g], lane ^ 32); T[g] = G[g] + Hs[g]; }
            float Bs[4]; Bs[3] = 0.f; Bs[2] = T[3]; Bs[1] = T[3] + T[2]; Bs[0] = Bs[1] + T[1];
            const float total = Bs[0] + T[0];
            float A[16];
#pragma unroll
            for (int g = 0; g < 4; ++g) {
                const float off = R + Bs[g] + (h == 0 ? Hs[g] : 0.f);
                const float c3 = off, c2 = c3 + l[4 * g + 3], c1 = c2 + l[4 * g + 2], c0 = c1 + l[4 * g + 1];
                const float cc[4] = {c0, c1, c2, c3};
#pragma unroll
                for (int e = 0; e < 4; ++e) { const int i = 4 * g + e; const bool valid = !diag || (crow(i, h) < r); const float a = fast_exp(s[i] + l[i] + cc[e]); A[i] = valid ? a : 0.f; }
            }
            R += total;
#pragma unroll
            for (int u = 0; u < 2; ++u) {
                u32x4 pa; pa.x = pk2(A[8 * u], A[8 * u + 1]); pa.y = pk2(A[8 * u + 2], A[8 * u + 3]); pa.z = pk2(A[8 * u + 4], A[8 * u + 5]); pa.w = pk2(A[8 * u + 6], A[8 * u + 7]);
#pragma unroll
                for (int d = 0; d < 4; ++d) o[d] = MFMA32(__builtin_bit_cast(bf16x8, vf[d][u]), __builtin_bit_cast(bf16x8, pa), o[d]);
            }
            if (__all(R < -104.f)) break;
#pragma unroll
            for (int st = 0; st < 8; ++st) kf[st] = kfn[st];
        }
#undef SB_LOAD_K
#undef SB_LOAD_V
        const bf16_t* sgp = SG + (tokbase + 32 * qt + r) * 1024 + hd * 128 + 4 * h; bf16_t* ybp = (bf16_t*)(P.ws + WS_YB) + (tokbase + 32 * qt + r) * 1024 + hd * 128 + 4 * h;
#pragma unroll
        for (int d = 0; d < 4; ++d)
#pragma unroll
            for (int g = 0; g < 4; ++g) { const bf16_t* pp = sgp + 32 * d + 8 * g; const u32x2 gv = *(const u32x2*)pp;
                const float g0 = bf_lo(gv.x), g1 = bf_hi(gv.x), g2 = bf_lo(gv.y), g3 = bf_hi(gv.y);
                u32x2 wv; wv.x = pk2(o[d][4 * g] * (g0 * sigmoidf_(g0)), o[d][4 * g + 1] * (g1 * sigmoidf_(g1)));
                wv.y = pk2(o[d][4 * g + 2] * (g2 * sigmoidf_(g2)), o[d][4 * g + 3] * (g3 * sigmoidf_(g3))); *(u32x2*)(ybp + 32 * d + 8 * g) = wv; }
    }
}

__device__ __forceinline__ void final_ln(const Params& P) {
    const int tid = tid_opaque(), wave = tid >> 6, lane = tid & 63;
    const int nw = gridDim.x * 8;
    for (int row = blockIdx.x * 8 + wave; row < TOK; row += 2 * nw) {
        const int row2 = row + nw;
        f32x4* xa = (f32x4*)(P.out + (size_t)row * DM) + lane; f32x4* xb = (f32x4*)(P.out + (size_t)row2 * DM) + lane;
        f32x4 va[8], vb[8]; float sa = 0.f, sb = 0.f;
#pragma unroll
        for (int j = 0; j < 8; ++j) { va[j] = xa[64 * j]; vb[j] = xb[64 * j]; }
#pragma unroll
        for (int j = 0; j < 8; ++j) { sa += (va[j][0] + va[j][1]) + (va[j][2] + va[j][3]); sb += (vb[j][0] + vb[j][1]) + (vb[j][2] + vb[j][3]); }
        const float ma = wave_sum(sa, lane) * (1.f / DM), mb = wave_sum(sb, lane) * (1.f / DM); float qa = 0.f, qb = 0.f;
#pragma unroll
        for (int j = 0; j < 8; ++j) { va[j] = va[j] - ma; vb[j] = vb[j] - mb;
            qa += (va[j][0] * va[j][0] + va[j][1] * va[j][1]) + (va[j][2] * va[j][2] + va[j][3] * va[j][3]);
            qb += (vb[j][0] * vb[j][0] + vb[j][1] * vb[j][1]) + (vb[j][2] * vb[j][2] + vb[j][3] * vb[j][3]); }
        const float ra = 1.f / sqrtf(wave_sum(qa, lane) * (1.f / DM) + LN_EPS), rb = 1.f / sqrtf(wave_sum(qb, lane) * (1.f / DM) + LN_EPS);
#pragma unroll
        for (int j = 0; j < 8; ++j) { const f32x4 g = *((const f32x4*)P.ln_g + lane + 64 * j), bb = *((const f32x4*)P.ln_b + lane + 64 * j);
            xa[64 * j] = va[j] * ra * g + bb; xb[64 * j] = vb[j] * rb * g + bb; }
    }
}

#define XB_TMO      128
#define XB_XCNT(j)  (256  + 64 * (j))
#define XB_XSUB(j)  (1280 + 64 * (j))
#define XB_XGEN(j)  (2304 + 64 * (j))
#define XB_TOP      3328
#define XB_TOPGEN   3392
#define XCD_BAR_WORDS 3456
#define XB_SPIN_CAP (1u << 18)
__device__ __forceinline__ unsigned xb_ld(unsigned* p)              { return __hip_atomic_load(p, __ATOMIC_RELAXED, __HIP_MEMORY_SCOPE_AGENT); }
__device__ __forceinline__ unsigned xb_add(unsigned* p, unsigned v) { return __hip_atomic_fetch_add(p, v, __ATOMIC_RELAXED, __HIP_MEMORY_SCOPE_AGENT); }
__device__ __forceinline__ unsigned xb_xcc_id() { return (unsigned)__builtin_amdgcn_s_getreg((3 << 11) | 20) & 0xFu; }
#define XB_SPIN(cond, bar) do { unsigned _sp = 0; while (cond) { __builtin_amdgcn_s_sleep(1); \
    if ((++_sp & 255u) == 0u) { if (xb_ld(&(bar)[XB_TMO])) break; if (_sp > XB_SPIN_CAP) { atomicAdd(&(bar)[XB_TMO], 1u); break; } } } } while (0)
__device__ __forceinline__ void xcd_barrier_complete(unsigned* bar, unsigned x, unsigned& nloc, unsigned& nx) {
    const unsigned G = gridDim.x * gridDim.y * gridDim.z;
    unsigned sum, cnt, mine, sp = 0u;
    for (;;) {
        sum = 0u; cnt = 0u; mine = 0u;
#pragma unroll
        for (unsigned j = 0; j < 16; ++j) { const unsigned c = xb_ld(&bar[XB_XCNT(j)]); sum += c; cnt += (c > 0u) ? 1u : 0u; mine = (j == x) ? c : mine; }
        if (sum == G) break;
        __builtin_amdgcn_s_sleep(1);
        if ((++sp & 255u) == 0u) { if (xb_ld(&bar[XB_TMO])) break; if (sp > XB_SPIN_CAP) { atomicAdd(&bar[XB_TMO], 1u); break; } }
    }
    nloc = mine > 0u ? mine : 1u; nx = cnt > 0u ? cnt : 1u;
}
__device__ __forceinline__ void xcd_barrier(unsigned* bar, volatile LAS unsigned* st) {
    asm volatile("s_waitcnt vmcnt(0)" ::: "memory");
    __syncthreads();
    if (tid_opaque() == 0) {
        const unsigned x = xb_xcc_id();
        __builtin_amdgcn_s_waitcnt(0);
        unsigned nloc = st[0], nx = st[1];
        if (nloc == 0u) { xcd_barrier_complete(bar, x, nloc, nx); st[0] = nloc; st[1] = nx; }
        const unsigned old = xb_add(&bar[XB_XSUB(x)], 1u);
        const unsigned gen = old / nloc;
        if (old + 1u == (gen + 1u) * nloc) {
            __builtin_amdgcn_fence(__ATOMIC_RELEASE, "agent");
            asm volatile("s_waitcnt vmcnt(0)" ::: "memory");
            const unsigned og = xb_add(&bar[XB_TOP], 1u);
            const unsigned tg = og / nx;
            if (og + 1u == (tg + 1u) * nx) xb_add(&bar[XB_TOPGEN], 1u);
            else XB_SPIN(xb_ld(&bar[XB_TOPGEN]) == tg, bar);
            __builtin_amdgcn_fence(__ATOMIC_ACQUIRE, "agent");
            xb_add(&bar[XB_XGEN(x)], 1u);
            asm volatile("s_waitcnt vmcnt(0)" ::: "memory");
        } else {
            XB_SPIN(xb_ld(&bar[XB_XGEN(x)]) == gen, bar);
            __builtin_amdgcn_fence(__ATOMIC_ACQUIRE, "agent");
            asm volatile("s_waitcnt vmcnt(0)" ::: "memory");
        }
    }
    __syncthreads();
}

__device__ __forceinline__ void subgrid_barrier(unsigned* bar, unsigned n) {
    asm volatile("s_waitcnt vmcnt(0)" ::: "memory");
    __syncthreads();
    if (tid_opaque() == 0) {
        __builtin_amdgcn_s_waitcnt(0);
        __builtin_amdgcn_fence(__ATOMIC_RELEASE, "agent");
        asm volatile("s_waitcnt vmcnt(0)" ::: "memory");
        (void)xb_add(&bar[0], 1u);
        XB_SPIN(xb_ld(&bar[0]) < n, bar);
        __builtin_amdgcn_fence(__ATOMIC_ACQUIRE, "agent");
        asm volatile("s_waitcnt vmcnt(0)" ::: "memory");
    }
    __syncthreads();
}

struct EpiU {
    static constexpr bool PERM = true;
    int mode; const Params* Pp;
    __device__ __forceinline__ void operator()(AccRef acc, const Unit& u, int wr, int wc, int fr, int fq) const {
        const Params& P = *Pp; unsigned char* ws = P.ws;
        switch (mode) {
        case 0: { EpiProj E; E.QD = (bf16_t*)(ws + WS_QD); E.KI = (bf16_t*)P.out; E.KET = (bf16_t*)P.out + (size_t)TOK * 2048; E.HG = (bf16_t*)(ws + WS_HG); E.SQ = (bf16_t*)(ws + WS_SQ);
                  E.SK = (bf16_t*)(ws + WS_SK); E.SG = (bf16_t*)(ws + WS_SG); E.DEC = (float*)(ws + WS_DEC); E.lbl = P.lb_logits; E(acc, u, wr, wc, fr, fq); } break;
        case 1: { EpiVT E; E.dst = (bf16_t*)(ws + WS_VT); E(acc, u, wr, wc, fr, fq); } break;
        case 2: { EpiGate E; E.ga = ws + WS_GA; E.gb = ws + WS_GB; E.bias = P.b_merge; E(acc, u, wr, wc, fr, fq); } break;
        case 3: { EpiMul E; E.m1 = (bf16_t*)(ws + WS_SQ); E.G = ws + WS_GB; E(acc, u, wr, wc, fr, fq); } break;
        case 4: { EpiMulAdd E; E.mo = (bf16_t*)(ws + WS_SQ); E.m1 = (const bf16_t*)(ws + WS_SQ); E.G = ws + WS_GA; E(acc, u, wr, wc, fr, fq); } break;
        case 6: { EpiOut E; E.r = P.out; E.rb = (bf16_t*)(ws + WS_QD); E.x = P.x; E.stats = (const float*)(ws + WS_STATS); E.g = P.ln_in_g; E.b = P.ln_in_b; E(acc, u, wr, wc, fr, fq); } break;
        case 7: { EpiPlain E; E.dst = (bf16_t*)(ws + WS_VT); E.ld = 2048; E(acc, u, wr, wc, fr, fq); } break;
        default: { EpiFinal E; E.r = P.out; E.pe = (const bf16_t*)(ws + WS_VT); E.bias = P.b_pg; E(acc, u, wr, wc, fr, fq); } break;
        }
    }
};
__device__ __forceinline__ void gemm_job(const Params& P, int job, LAS unsigned char* lds, int G, int c) {
    unsigned char* ws = P.ws;
    size_t a, b; int M = TOK, N = 2048, K = 2048;
    switch (job) {
    case 0: a = WS_H; b = WS_WTMAIN; N = 9216; break;
    case 1: a = WS_WTVT; b = WS_H; M = 3072; N = TOK; break;
    case 2: a = WS_H; b = WS_WMT; N = 4096; break;
    case 3: a = WS_YB; b = WS_WBT; K = 1024; break;
    case 4: a = WS_HG; b = WS_WAT; break;
    case 6: a = WS_SQ; b = WS_WOT; break;
    case 7: a = WS_PB; b = WS_WPET; K = 256; break;
    default: a = WS_QD; b = WS_WPGT; break;
    }
    pg8::Gemm g{(const bf16_t*)(ws + a), (const bf16_t*)(ws + b), M, N, K};
    pg8::StaticOrder S; S.init(M, N, G, c);
    EpiU E; E.mode = job; E.Pp = &P;
    pg8::gemm_phase(lds, g, S, E);
}
__device__ __forceinline__ void run_phase(const Params& P, int ph, LAS unsigned char* lds) {
    int j0 = 0, j1 = 0, G = (int)gridDim.x, c = (int)blockIdx.x;
    if (ph == 0) { phase0(P, lds); }
    else if (ph == 2) {
        if (c < 32) hgrn2_seq(P, lds, P.out, c);
        else { late_transposes(P, lds, 32); sb_attention(P, 32); j0 = 2; j1 = 4; G -= 32; c -= 32; }
    }
    else if (ph == 6) { final_ln(P); }
    else if (ph == 1) { j0 = 0; j1 = 2; }
    else if (ph == 3) { j0 = 4; j1 = 5; }
    else if (ph == 4) { j0 = 6; j1 = 7; }
    else { j0 = 7; j1 = 9; }
#pragma unroll 1
    for (int j = j0; j < j1; ++j) {
        if (ph == 2 && j == 3) subgrid_barrier((unsigned*)(P.ws + WS_BAR), (unsigned)G);
        gemm_job(P, j, lds, G, c);
    }
}
#ifndef MK_PROG
#define MK_PROG 0, 1, 2, 3, 4, 5, 6
#endif
__device__ __constant__ const int PROG_D[] = {MK_PROG};
static const int PROG_H[] = {MK_PROG};
constexpr int NPHASES = sizeof(PROG_H) / sizeof(int);
constexpr int LDS_BYTES = 147456 + 16;

constexpr int LDS_XB = 147456;
template <bool COOP> __global__ __launch_bounds__(512, 2) void mega(Params P) {
    extern __shared__ __attribute__((aligned(16))) unsigned char shm[];
    LAS unsigned char* lds = (LAS unsigned char*)shm;
    unsigned* bar = (unsigned*)(P.ws + WS_BAR);
    volatile LAS unsigned* st = (volatile LAS unsigned*)(lds + LDS_XB);
    if constexpr (COOP) {
        if (tid_opaque() == 0) { st[0] = 0u; st[1] = 0u; (void)xb_add(&bar[XB_XCNT(xb_xcc_id())], 1u); }
        __syncthreads();
        if (P.ph_hi < 0) cg::this_grid().sync();
    }
#pragma unroll 1
    for (int pi = P.ph_lo; pi < P.ph_hi; ++pi) {
        const int ph = PROG_D[pi];
        run_phase(P, ph, lds);
        if constexpr (COOP) { if (pi + 1 < P.ph_hi) xcd_barrier(bar, st); }
    }
}

extern "C" void kernel_launch(void* const* d_in, const int* in_sizes, int n_in, void* d_out, int out_size, void* d_ws, size_t ws_size, hipStream_t stream) {
    static int grid = 0;
    if (grid == 0) {
        if (n_in != 17 || out_size != TOK * DM || ws_size < WS_END) { fprintf(stderr, "kernel_launch: unexpected shapes (n_in %d out %d ws %zu need %zu)\n", n_in, out_size, ws_size, (size_t)WS_END); grid = -1; return; }
        int dev = 0, cus = 0, per_cu = 0;
        hipGetDevice(&dev); hipDeviceGetAttribute(&cus, hipDeviceAttributeMultiprocessorCount, dev);
        hipFuncSetAttribute((const void*)mega<true>, hipFuncAttributeMaxDynamicSharedMemorySize, LDS_BYTES);
#if MK_MULTI
        hipFuncSetAttribute((const void*)mega<false>, hipFuncAttributeMaxDynamicSharedMemorySize, LDS_BYTES);
#endif
        hipOccupancyMaxActiveBlocksPerMultiprocessor(&per_cu, (const void*)mega<true>, 512, LDS_BYTES);
        if (per_cu < 1) { fprintf(stderr, "kernel_launch: occupancy query says %d blocks/CU\n", per_cu); per_cu = 1; }
        (void)hipGetLastError();
        grid = cus;
    }
    if (grid < 0) return;
    Params P{};
    P.x = (const float*)d_in[0]; P.p = (const float*)d_in[1]; P.ln_in_g = (const float*)d_in[2]; P.ln_in_b = (const float*)d_in[3]; P.w_in = (const float*)d_in[4];
    P.lb_logits = (const float*)d_in[5]; P.hg_norm_g = (const float*)d_in[6]; P.w_merge = (const float*)d_in[7]; P.b_merge = (const float*)d_in[8];
    P.w_br_hg = (const float*)d_in[9]; P.w_br_sb = (const float*)d_in[10]; P.w_out = (const float*)d_in[11]; P.w_pe = (const float*)d_in[12];
    P.w_pg = (const float*)d_in[13]; P.b_pg = (const float*)d_in[14]; P.ln_g = (const float*)d_in[15]; P.ln_b = (const float*)d_in[16];
    P.out = (float*)d_out; P.ws = (unsigned char*)d_ws;
#if MK_MULTI
    for (int ph = 0; ph < NPHASES; ++ph) { P.ph_lo = ph; P.ph_hi = ph + 1; hipLaunchKernelGGL(mega<false>, dim3(grid), dim3(512), LDS_BYTES, stream, P); }
#else
    P.ph_lo = 0; P.ph_hi = NPHASES;
    if (hipMemsetAsync((char*)d_ws + WS_BAR, 0, XCD_BAR_WORDS * sizeof(unsigned), stream) != hipSuccess) { fprintf(stderr, "kernel_launch: memset of the barrier words failed\n"); return; }
    void* args[] = {&P};
    hipError_t e = hipLaunchCooperativeKernel((const void*)mega<true>, dim3(grid), dim3(512), args, LDS_BYTES, stream);
    if (e != hipSuccess) fprintf(stderr, "cooperative launch failed: %s (grid %d)\n", hipGetErrorString(e), grid);
#endif
}
```

```cpp
#include <hip/hip_runtime.h>
#include <hip/hip_cooperative_groups.h>
#include <cstdio>
namespace cg = cooperative_groups;

#ifndef MK_MULTI
#define MK_MULTI 0
#endif

#define LAS __attribute__((address_space(3)))
typedef unsigned short bf16_t;
typedef short bf16x8 __attribute__((ext_vector_type(8)));
typedef float f32x2 __attribute__((ext_vector_type(2)));
typedef float f32x4 __attribute__((ext_vector_type(4)));
typedef float f32x16 __attribute__((ext_vector_type(16)));
typedef unsigned u32x4 __attribute__((ext_vector_type(4)));
typedef unsigned u32x2 __attribute__((ext_vector_type(2)));
typedef __bf16 bf2_t __attribute__((ext_vector_type(2)));

constexpr int TOK = 32768, DM = 2048, SEQ_T = 16384;
constexpr float LN_EPS = 1e-5f;
constexpr float DN_ALPHA = 1.189207115002721f;

constexpr size_t WS_WTMAIN = 0;
constexpr size_t WS_WTVT   = WS_WTMAIN + (size_t)9216 * 2048 * 2;
constexpr size_t WS_WMT    = WS_WTVT + (size_t)3072 * 2048 * 2;
constexpr size_t WS_WAT    = WS_WMT + (size_t)4096 * 2048 * 2;
constexpr size_t WS_WBT    = WS_WAT + (size_t)2048 * 2048 * 2;
constexpr size_t WS_WOT    = WS_WBT + (size_t)2048 * 1024 * 2;
constexpr size_t WS_WPGT   = WS_WOT + (size_t)2048 * 2048 * 2;
constexpr size_t WS_WPET   = WS_WPGT + (size_t)2048 * 2048 * 2;
constexpr size_t WS_H      = WS_WPET + (size_t)2048 * 256 * 2;
constexpr size_t WS_QD     = WS_H + (size_t)TOK * 2048 * 2;
constexpr size_t WS_HG     = WS_QD + (size_t)TOK * 2048 * 2;
constexpr size_t WS_VT     = WS_HG + (size_t)TOK * 2048 * 2;
constexpr size_t WS_SQ     = WS_VT + (size_t)3072 * TOK * 2;
constexpr size_t WS_SK     = WS_SQ + (size_t)TOK * 1024 * 2;
constexpr size_t WS_SG     = WS_SK + (size_t)TOK * 1024 * 2;
constexpr size_t WS_PB     = WS_SG + (size_t)TOK * 1024 * 2;
constexpr size_t WS_DEC    = WS_PB + (size_t)TOK * 256 * 2;
constexpr size_t WS_STATS  = WS_DEC + (size_t)512 * 2048 * 4;
constexpr size_t WS_YB     = WS_SG;
constexpr size_t WS_GA     = WS_STATS + (size_t)TOK * 2 * 4;
constexpr size_t WS_GB     = WS_GA + (size_t)TOK * 2048;
constexpr size_t WS_BAR    = WS_GB + (size_t)TOK * 2048;
constexpr size_t WS_END    = WS_BAR + 16384;

struct Params {
    const float *x, *p, *ln_in_g, *ln_in_b, *w_in, *lb_logits, *hg_norm_g, *w_merge, *b_merge, *w_br_hg, *w_br_sb, *w_out, *w_pe, *w_pg, *b_pg, *ln_g, *ln_b;
    float* out; unsigned char* ws;
    int ph_lo, ph_hi;
};

__device__ __forceinline__ unsigned pk2(float lo, float hi) { f32x2 v = {lo, hi}; bf2_t b = __builtin_convertvector(v, bf2_t); return __builtin_bit_cast(unsigned, b); }
__device__ __forceinline__ float bf_lo(unsigned u) { return __uint_as_float(u << 16); }
__device__ __forceinline__ float bf_hi(unsigned u) { return __uint_as_float(u & 0xffff0000u); }
__device__ __forceinline__ float fast_exp(float x) { return __builtin_amdgcn_exp2f(x * 1.4426950408889634f); }
__device__ __forceinline__ float fast_log(float x) { return __builtin_amdgcn_logf(x) * 0.6931471805599453f; }
__device__ __forceinline__ float fast_rcp(float x) { return __builtin_amdgcn_rcpf(x); }
__device__ __forceinline__ float sigmoidf_(float x) { return fast_rcp(1.f + fast_exp(-x)); }
__device__ __forceinline__ float lane_read(float v, int src_lane) { return __int_as_float(__builtin_amdgcn_ds_bpermute(src_lane << 2, __float_as_int(v))); }
__device__ __forceinline__ float wave_sum(float v, int lane) {
#pragma unroll
    for (int o = 1; o < 64; o <<= 1) v += lane_read(v, lane ^ o);
    return v;
}
__device__ __forceinline__ int tid_opaque() { int t = threadIdx.x; asm volatile("" : "+v"(t)); return t; }
#define MFMA32(a, b, c) __builtin_amdgcn_mfma_f32_32x32x16_bf16((a), (b), (c), 0, 0, 0)
__device__ __forceinline__ int crow(int reg, int h) { return (reg & 3) + 8 * (reg >> 2) + 4 * h; }

namespace pg8 {
constexpr int BM = 256, BK = 64, HALF = 128, HTB = HALF * BK * 2, STAGE_BYTES = 8 * HTB, NXCD = 8, WGM = 8;
__device__ __forceinline__ int lds_byte(int r, int c) { const int st = (r >> 4) * 2 + (c >> 5), rr = r & 15, cc = c & 31, ob = rr * 64 + cc * 2; return st * 1024 + (ob ^ (((ob >> 9) & 1) << 5)); }
__device__ __forceinline__ void stage_rc(int b, int& R, int& C) { const int st = b / 1024, sb = b % 1024, swz = sb ^ (((sb >> 9) & 1) << 5); R = (st >> 1) * 16 + swz / 64; C = (st & 1) * 32 + (swz % 64) / 2; }
__device__ __forceinline__ int perm32(int rho) { const int n = rho >> 4, i = rho & 15; return 8 * (i >> 2) + 4 * n + (i & 3); }
struct Unit { int pm, pn; };
struct Gemm { const bf16_t* A; const bf16_t* Bt; int M, N, K; };
struct StaticOrder {
    int nM, nN, nwg, G, c;
    __device__ void init(int M, int N, int G_, int c_) { nM = M / BM; nN = N / BM; nwg = nM * nN; G = G_; c = c_; }
    __device__ bool next(int i, Unit& u) const {
        const long L = (long)i * G + c; if (L >= nwg) return false;
        int wgid = (int)L; { const int q = nwg / NXCD, r = nwg % NXCD, xcd = wgid % NXCD, off = wgid / NXCD; wgid = (xcd < r ? xcd * (q + 1) : r * (q + 1) + (xcd - r) * q) + off; }
        const int nig = WGM * nN, gid = wgid / nig, fm = gid * WGM, gsz = (nM - fm) < WGM ? (nM - fm) : WGM;
        u.pm = fm + ((wgid % nig) % gsz); u.pn = (wgid % nig) / gsz; return true;
    }
};
template <class Epi>
__device__ __forceinline__ void gemm_phase(LAS unsigned char* lds, const Gemm g, const StaticOrder& S, const Epi& E) {
    const int K = g.K, nt = K / BK;
    int wr, wc, fr, fq, aoff, boff; unsigned voffA[2], voffB[2], ldsw;
#define PG8_SETUP() do { const int tid = tid_opaque(), wid = __builtin_amdgcn_readfirstlane(tid >> 6), lane = tid & 63; wr = wid >> 2; wc = wid & 3; fr = lane & 15; fq = lane >> 4; \
        _Pragma("unroll") for (int i = 0; i < 2; ++i) { int R, C; stage_rc(tid * 16 + i * 8192, R, C); const int Rb = (R & ~31) + perm32(R & 31); \
            voffA[i] = (unsigned)(R * K + C) * 2u; voffB[i] = (unsigned)(Rb * K + C) * 2u; } \
        ldsw = (unsigned)wid * 1024u; aoff = lds_byte(wr * 64 + fr, fq * 8); boff = lds_byte(wc * 32 + fr, fq * 8); } while (0)
    PG8_SETUP();
    const size_t kstep = (size_t)(BK * 2);
    const size_t hstep = (size_t)HALF * K * 2;
    const size_t tstep = 2 * hstep;
#define PG8_SA(b, h) (((b) * 2 + (h)) * HTB)
#define PG8_SB(b, h) ((4 + (b) * 2 + (h)) * HTB)
#define PG8_STAGE(bufoff, gbase, voff) do { _Pragma("unroll") for (int _i = 0; _i < 2; ++_i) \
        __builtin_amdgcn_global_load_lds((const unsigned*)((const char*)(gbase) + (voff)[_i]), (LAS unsigned*)(lds + (bufoff) + ldsw + _i * 8192), 16, 0, 0); } while (0)
#define PG8_LDA(dst, b, h) do { _Pragma("unroll") for (int m = 0; m < 4; ++m) _Pragma("unroll") for (int k = 0; k < 2; ++k) dst[m][k] = *(const LAS bf16x8*)(lds + PG8_SA(b, h) + aoff + m * 2048 + k * 1024); } while (0)
#define PG8_LDB(dst, b, h) do { _Pragma("unroll") for (int n = 0; n < 2; ++n) _Pragma("unroll") for (int k = 0; k < 2; ++k) dst[n][k] = *(const LAS bf16x8*)(lds + PG8_SB(b, h) + boff + n * 2048 + k * 1024); } while (0)
#define PG8_MMA(ai, bj, At, Bt) do { __builtin_amdgcn_s_setprio(1); _Pragma("unroll") for (int m = 0; m < 4; ++m) _Pragma("unroll") for (int n = 0; n < 2; ++n) _Pragma("unroll") for (int k = 0; k < 2; ++k) \
        acc[ai][bj][m][n] = __builtin_amdgcn_mfma_f32_16x16x32_bf16(Bt[n][k], At[m][k], acc[ai][bj][m][n], 0, 0, 0); __builtin_amdgcn_s_setprio(0); } while (0)
#define PG8_WAIT_V(n) asm volatile("s_waitcnt vmcnt(" #n ")" ::: "memory")
#define PG8_WAIT_L(n) asm volatile("s_waitcnt lgkmcnt(" #n ")" ::: "memory")
#define PG8_BAR __builtin_amdgcn_s_barrier()
#define PG8_SCHED __builtin_amdgcn_sched_barrier(0)
    Unit cur, nxt; int ui = 0;
    if (!S.next(0, cur)) return;
    f32x4 acc[2][2][4][2];
#pragma unroll
    for (int a = 0; a < 2; ++a)
#pragma unroll
        for (int b = 0; b < 2; ++b)
#pragma unroll
            for (int m = 0; m < 4; ++m)
#pragma unroll
                for (int n = 0; n < 2; ++n) acc[a][b][m][n] = (f32x4){0.f, 0.f, 0.f, 0.f};
    bf16x8 At[4][2], B0[2][2], B1[2][2];
    const char* cA = (const char*)g.A + (size_t)cur.pm * tstep; const char* cB = (const char*)g.Bt + (size_t)cur.pn * tstep;
    PG8_WAIT_V(0);
    PG8_STAGE(PG8_SB(0, 0), cB, voffB); PG8_STAGE(PG8_SA(0, 0), cA, voffA); PG8_STAGE(PG8_SB(0, 1), cB + hstep, voffB); PG8_STAGE(PG8_SA(0, 1), cA + hstep, voffA);
    if (wr == 1) PG8_BAR;
    PG8_WAIT_V(4); PG8_BAR;
    PG8_STAGE(PG8_SB(1, 0), cB + kstep, voffB); PG8_STAGE(PG8_SA(1, 0), cA + kstep, voffA); PG8_STAGE(PG8_SB(1, 1), cB + hstep + kstep, voffB);
    PG8_WAIT_V(6); PG8_BAR;
    for (;;) {
        const bool has_next = S.next(ui + 1, nxt);
        const char* nA = has_next ? (const char*)g.A + (size_t)nxt.pm * tstep : cA; const char* nB = has_next ? (const char*)g.Bt + (size_t)nxt.pn * tstep : cB;
        for (int t = 0; t < nt; t += 2) {
            const bool last = (t == nt - 2);
            const char* a1 = cA + (size_t)(t + 1) * kstep;
            const char* a2 = last ? nA : cA + (size_t)(t + 2) * kstep; const char* b2 = last ? nB : cB + (size_t)(t + 2) * kstep;
            const char* a3 = a2 + kstep; const char* b3 = b2 + kstep;
            PG8_LDB(B0, 0, 0); PG8_SCHED; PG8_LDA(At, 0, 0); PG8_STAGE(PG8_SA(1, 1), a1 + hstep, voffA);
            PG8_WAIT_L(8); PG8_BAR; PG8_WAIT_L(0); PG8_MMA(0, 0, At, B0); PG8_BAR; PG8_SCHED;
            PG8_LDB(B1, 0, 1); PG8_STAGE(PG8_SB(0, 0), b2, voffB);
            PG8_BAR; PG8_WAIT_L(0); PG8_MMA(0, 1, At, B1); PG8_BAR;
            PG8_LDA(At, 0, 1); PG8_STAGE(PG8_SA(0, 0), a2, voffA);
            PG8_BAR; PG8_WAIT_L(0); PG8_MMA(1, 0, At, B0); PG8_BAR; PG8_SCHED;
            PG8_STAGE(PG8_SB(0, 1), b2 + hstep, voffB);
            PG8_WAIT_V(6); PG8_BAR; PG8_MMA(1, 1, At, B1); PG8_BAR;
            PG8_LDB(B0, 1, 0); PG8_SCHED; PG8_LDA(At, 1, 0); PG8_STAGE(PG8_SA(0, 1), a2 + hstep, voffA);
            PG8_WAIT_L(8); PG8_BAR; PG8_WAIT_L(0); PG8_MMA(0, 0, At, B0); PG8_BAR; PG8_SCHED;
            PG8_LDB(B1, 1, 1); PG8_STAGE(PG8_SB(1, 0), b3, voffB);
            PG8_BAR; PG8_WAIT_L(0); PG8_MMA(0, 1, At, B1); PG8_BAR;
            PG8_LDA(At, 1, 1); PG8_STAGE(PG8_SA(1, 0), a3, voffA);
            PG8_BAR; PG8_WAIT_L(0); PG8_MMA(1, 0, At, B0); PG8_BAR; PG8_SCHED;
            PG8_STAGE(PG8_SB(1, 1), b3 + hstep, voffB);
            PG8_WAIT_V(6); PG8_BAR; PG8_MMA(1, 1, At, B1); PG8_BAR;
        }
        E(acc, cur, wr, wc, fr, fq);
        PG8_WAIT_V(0);
        if (!has_next) break;
#pragma unroll
        for (int a = 0; a < 2; ++a)
#pragma unroll
            for (int b = 0; b < 2; ++b)
#pragma unroll
                for (int m = 0; m < 4; ++m)
#pragma unroll
                    for (int n = 0; n < 2; ++n) acc[a][b][m][n] = (f32x4){0.f, 0.f, 0.f, 0.f};
        cur = nxt; cA = nA; cB = nB; ++ui;
        PG8_SETUP();
    }
    PG8_WAIT_V(0);
    if (wr == 0) PG8_BAR;
    PG8_BAR;
#undef PG8_SETUP
#undef PG8_SA
#undef PG8_SB
#undef PG8_STAGE
#undef PG8_LDA
#undef PG8_LDB
#undef PG8_MMA
#undef PG8_WAIT_V
#undef PG8_WAIT_L
#undef PG8_BAR
#undef PG8_SCHED
}
}
using pg8::Unit;
typedef const f32x4 (&AccRef)[2][2][4][2];

__device__ __forceinline__ u32x4 pack8(f32x4 a, f32x4 b) { u32x4 w; w.x = pk2(a[0], a[1]); w.y = pk2(a[2], a[3]); w.z = pk2(b[0], b[1]); w.w = pk2(b[2], b[3]); return w; }
__device__ __forceinline__ void unpack8(u32x4 w, f32x4& a, f32x4& b) { a[0] = bf_lo(w.x); a[1] = bf_hi(w.x); a[2] = bf_lo(w.y); a[3] = bf_hi(w.y); b[0] = bf_lo(w.z); b[1] = bf_hi(w.z); b[2] = bf_lo(w.w); b[3] = bf_hi(w.w); }

__device__ __forceinline__ void store_plain(AccRef acc, bf16_t* dst, size_t ld, int rowt, int colt, int wr, int wc, int fr, int fq) {
    const int row0 = rowt * 256 + wr * 64 + fr, col0 = colt * 256 + wc * 32 + 8 * fq;
#pragma unroll
    for (int ai = 0; ai < 2; ++ai)
#pragma unroll
        for (int m = 0; m < 4; ++m) { bf16_t* rowp = dst + (size_t)(row0 + ai * 128 + m * 16) * ld + col0;
#pragma unroll
            for (int bj = 0; bj < 2; ++bj) *(u32x4*)(rowp + bj * 128) = pack8(acc[ai][bj][m][0], acc[ai][bj][m][1]); __builtin_amdgcn_sched_barrier(0); }
}

template <int CTRL> __device__ __forceinline__ float dpp_mov0(float x) { return __int_as_float(__builtin_amdgcn_update_dpp(0, __float_as_int(x), CTRL, 0xf, 0xf, true)); }
__device__ __forceinline__ float scan16(float x) { x += dpp_mov0<0x111>(x); x += dpp_mov0<0x112>(x); x += dpp_mov0<0x114>(x); x += dpp_mov0<0x118>(x); return x; }

struct EpiProj {
    static constexpr bool PERM = true;
    bf16_t *QD, *KI, *KET, *HG, *SQ, *SK, *SG; float* DEC; const float* lbl;
    __device__ __forceinline__ void operator()(AccRef acc, const Unit& u, int wr, int wc, int fr, int fq) const {
        if (u.pn >= 16) {
            if (u.pn < 24) store_plain(acc, HG, 2048, u.pm, u.pn - 16, wr, wc, fr, fq);
            else if (u.pn < 28) store_plain(acc, SQ, 1024, u.pm, u.pn - 24, wr, wc, fr, fq);
            else if (u.pn < 32) store_plain(acc, SK, 1024, u.pm, u.pn - 28, wr, wc, fr, fq);
            else store_plain(acc, SG, 1024, u.pm, u.pn - 32, wr, wc, fr, fq);
            return;
        }
        const int head = u.pn, kk0 = wc * 32 + 8 * fq, hc0 = head * 128 + kk0;
        const int lane = fr + 16 * fq;
        float lbreg; { const int cc = head * 128 + wc * 32 + (lane & 31); const float l0 = lbl[cc], l1 = lbl[2048 + cc]; lbreg = fast_rcp(1.f + fast_exp(l1 - l0)); }
#pragma unroll
        for (int ai = 0; ai < 2; ++ai) {
            const int rowb = u.pm * 256 + ai * 128 + wr * 64, row0 = rowb + fr, chunk = rowb >> 6;
            unsigned qdp[4][4], kip[4][4];
#pragma unroll
            for (int n = 0; n < 2; ++n) {
#pragma unroll
                for (int jp = 0; jp < 2; ++jp) {
                    float qd2[4], ki2[4], dec2;
#pragma unroll
                    for (int e = 0; e < 2; ++e) {
                        const int j = 2 * jp + e, c = 4 * n + j;
                        const float lb = lane_read(lbreg, 8 * fq + c);
                        float lf[4], kv[4];
#pragma unroll
                        for (int m = 0; m < 4; ++m) { const float xx = acc[ai][1][m][n][j]; const float f = lb + (1.f - lb) * sigmoidf_(xx); kv[m] = 1.f - f; lf[m] = scan16(fast_log(f)); }
                        const int src = lane | 15;
                        const float t0 = lane_read(lf[0], src), t1 = lane_read(lf[1], src), t2 = lane_read(lf[2], src), t3 = lane_read(lf[3], src);
                        float bc[4]; bc[0] = lf[0]; bc[1] = lf[1] + t0; bc[2] = lf[2] + (t0 + t1); bc[3] = lf[3] + (t0 + t1 + t2);
                        const float dec = fast_exp(t0 + t1 + t2 + t3);
#pragma unroll
                        for (int m = 0; m < 4; ++m) { const float ee = fast_exp(bc[m]); const float qd = acc[ai][0][m][n][j] * ee; const float ki = kv[m] * fast_rcp(ee);
                            const float ke = ki * dec; KET[(unsigned)((chunk * 2048 + hc0 + c) * 64 + fr + 16 * m)] = (bf16_t)(pk2(ke, 0.f) & 0xffffu);
                            if (e == 0) { qd2[m] = qd; ki2[m] = ki; }
                            else { qdp[m][2 * n + jp] = pk2(qd2[m], qd); kip[m][2 * n + jp] = pk2(ki2[m], ki); } }
                        if (e == 0) dec2 = dec;
                        else if (fr == 0) { float* dp = DEC + (unsigned)(chunk * 2048 + hc0 + 4 * n + 2 * jp); *(f32x2*)dp = (f32x2){dec2, dec}; }
                        __builtin_amdgcn_sched_barrier(0);
                    }
                }
            }
#pragma unroll
            for (int m = 0; m < 4; ++m) { const unsigned o = (unsigned)((row0 + 16 * m) * 2048 + hc0);
                u32x4 qa; qa.x = qdp[m][0]; qa.y = qdp[m][1]; qa.z = qdp[m][2]; qa.w = qdp[m][3]; *(u32x4*)(QD + o) = qa;
                u32x4 kb_; kb_.x = kip[m][0]; kb_.y = kip[m][1]; kb_.z = kip[m][2]; kb_.w = kip[m][3]; *(u32x4*)(KI + o) = kb_; }
        }
    }
};
struct EpiPlain {
    static constexpr bool PERM = true;
    bf16_t* dst; int ld;
    __device__ __forceinline__ void operator()(AccRef acc, const Unit& u, int wr, int wc, int fr, int fq) const { store_plain(acc, dst, (size_t)ld, u.pm, u.pn, wr, wc, fr, fq); }
};
struct EpiVT {
    static constexpr bool PERM = true;
    bf16_t* dst;
    __device__ __forceinline__ void operator()(AccRef acc, const Unit& u, int wr, int wc, int fr, int fq) const {
        const int row0 = u.pm * 256 + wr * 64 + fr, col0 = u.pn * 256 + wc * 32 + 8 * fq;
#pragma unroll
        for (int ai = 0; ai < 2; ++ai)
#pragma unroll
            for (int m = 0; m < 4; ++m)
#pragma unroll
                for (int bj = 0; bj < 2; ++bj) { const int row = row0 + ai * 128 + m * 16, col = col0 + bj * 128;
                    *(u32x4*)(dst + ((size_t)((col >> 6) * 3072 + row) * 64 + (col & 63))) = pack8(acc[ai][bj][m][0], acc[ai][bj][m][1]); __builtin_amdgcn_sched_barrier(0); }
    }
};
__device__ __forceinline__ unsigned q8(float g) { return (unsigned)(g * 255.f + 0.5f); }
__device__ __forceinline__ u32x2 pack8u(f32x4 a, f32x4 b) { u32x2 w; w.x = q8(a[0]) | (q8(a[1]) << 8) | (q8(a[2]) << 16) | (q8(a[3]) << 24); w.y = q8(b[0]) | (q8(b[1]) << 8) | (q8(b[2]) << 16) | (q8(b[3]) << 24); return w; }
__device__ __forceinline__ void unpack8u(u32x2 w, f32x4& a, f32x4& b) { const float k = 1.f / 255.f;
    a[0] = (float)(w.x & 255u) * k; a[1] = (float)((w.x >> 8) & 255u) * k; a[2] = (float)((w.x >> 16) & 255u) * k; a[3] = (float)(w.x >> 24) * k;
    b[0] = (float)(w.y & 255u) * k; b[1] = (float)((w.y >> 8) & 255u) * k; b[2] = (float)((w.y >> 16) & 255u) * k; b[3] = (float)(w.y >> 24) * k; }
struct EpiGate {
    static constexpr bool PERM = true;
    unsigned char *ga, *gb; const float* bias;
    __device__ __forceinline__ void operator()(AccRef acc, const Unit& u, int wr, int wc, int fr, int fq) const {
        unsigned char* dst = u.pn < 8 ? ga : gb;
        const int row0 = u.pm * 256 + wr * 64 + fr, col0 = (u.pn & 7) * 256 + wc * 32 + 8 * fq, bcol0 = u.pn * 256 + wc * 32 + 8 * fq;
#pragma unroll
        for (int bj = 0; bj < 2; ++bj) { const f32x4 b0 = *(const f32x4*)(bias + bcol0 + bj * 128), b1 = *(const f32x4*)(bias + bcol0 + bj * 128 + 4);
#pragma unroll
            for (int ai = 0; ai < 2; ++ai)
#pragma unroll
                for (int m = 0; m < 4; ++m) { f32x4 v0 = acc[ai][bj][m][0] + b0, v1 = acc[ai][bj][m][1] + b1;
#pragma unroll
                    for (int j = 0; j < 4; ++j) { v0[j] = sigmoidf_(v0[j]); v1[j] = sigmoidf_(v1[j]); }
                    *(u32x2*)(dst + (size_t)(row0 + ai * 128 + m * 16) * 2048 + col0 + bj * 128) = pack8u(v0, v1); __builtin_amdgcn_sched_barrier(0); } }
    }
};
struct EpiMul {
    static constexpr bool PERM = true;
    bf16_t* m1; const unsigned char* G;
    __device__ __forceinline__ void operator()(AccRef acc, const Unit& u, int wr, int wc, int fr, int fq) const {
        const int row0 = u.pm * 256 + wr * 64 + fr, col0 = u.pn * 256 + wc * 32 + 8 * fq;
        u32x2 ng = *(const u32x2*)(G + (size_t)row0 * 2048 + col0);
#pragma unroll
        for (int it = 0; it < 16; ++it) { const int ai = it >> 3, m = (it >> 1) & 3, bj = it & 1;
            const size_t o = (size_t)(row0 + ai * 128 + m * 16) * 2048 + col0 + bj * 128;
            const u32x2 gv = ng;
            if (it + 1 < 16) { const int ai2 = (it + 1) >> 3, m2 = ((it + 1) >> 1) & 3, bj2 = (it + 1) & 1; ng = *(const u32x2*)(G + (size_t)(row0 + ai2 * 128 + m2 * 16) * 2048 + col0 + bj2 * 128); }
            __builtin_amdgcn_sched_barrier(0);
            f32x4 g0, g1; unpack8u(gv, g0, g1);
            *(u32x4*)(m1 + o) = pack8(acc[ai][bj][m][0] * g0, acc[ai][bj][m][1] * g1); __builtin_amdgcn_sched_barrier(0); }
    }
};
struct EpiMulAdd {
    static constexpr bool PERM = true;
    bf16_t* mo; const bf16_t* m1; const unsigned char* G;
    __device__ __forceinline__ void operator()(AccRef acc, const Unit& u, int wr, int wc, int fr, int fq) const {
        const int row0 = u.pm * 256 + wr * 64 + fr, col0 = u.pn * 256 + wc * 32 + 8 * fq;
        u32x2 ng = *(const u32x2*)(G + (size_t)row0 * 2048 + col0); u32x4 nm = *(const u32x4*)(m1 + (size_t)row0 * 2048 + col0);
#pragma unroll
        for (int it = 0; it < 16; ++it) { const int ai = it >> 3, m = (it >> 1) & 3, bj = it & 1;
            const size_t o = (size_t)(row0 + ai * 128 + m * 16) * 2048 + col0 + bj * 128;
            const u32x2 gv = ng; const u32x4 mv = nm;
            if (it + 1 < 16) { const int ai2 = (it + 1) >> 3, m2 = ((it + 1) >> 1) & 3, bj2 = (it + 1) & 1; const size_t o2 = (size_t)(row0 + ai2 * 128 + m2 * 16) * 2048 + col0 + bj2 * 128;
                ng = *(const u32x2*)(G + o2); nm = *(const u32x4*)(m1 + o2); }
            __builtin_amdgcn_sched_barrier(0);
            f32x4 g0, g1; unpack8u(gv, g0, g1); f32x4 a0, a1; unpack8(mv, a0, a1);
            *(u32x4*)(mo + o) = pack8(a0 + acc[ai][bj][m][0] * g0, a1 + acc[ai][bj][m][1] * g1); __builtin_amdgcn_sched_barrier(0); }
    }
};
struct EpiOut {
    static constexpr bool PERM = true;
    float* r; bf16_t* rb; const float *x, *stats, *g, *b;
    __device__ __forceinline__ void operator()(AccRef acc, const Unit& u, int wr, int wc, int fr, int fq) const {
        const int row0 = u.pm * 256 + wr * 64 + fr, col0 = u.pn * 256 + wc * 32 + 8 * fq;
#pragma unroll
        for (int bj = 0; bj < 2; ++bj) { const int c = col0 + bj * 128;
            const f32x4 g0 = *(const f32x4*)(g + c), g1 = *(const f32x4*)(g + c + 4), b0 = *(const f32x4*)(b + c), b1 = *(const f32x4*)(b + c + 4);
            f32x4 nx0, nx1; float nmean, nrstd;
            { const int row = row0; const size_t o = (size_t)row * 2048 + c; nmean = stats[2 * row]; nrstd = stats[2 * row + 1]; nx0 = *(const f32x4*)(x + o); nx1 = *(const f32x4*)(x + o + 4); }
#pragma unroll
            for (int it = 0; it < 8; ++it) { const int ai = it >> 2, m = it & 3;
                const int row = row0 + ai * 128 + m * 16; const size_t o = (size_t)row * 2048 + c;
                const f32x4 x0 = nx0, x1 = nx1; const float mean = nmean, rstd = nrstd;
                if (it + 1 < 8) { const int ai2 = (it + 1) >> 2, m2 = (it + 1) & 3; const int row2 = row0 + ai2 * 128 + m2 * 16; const size_t o2 = (size_t)row2 * 2048 + c;
                    nmean = stats[2 * row2]; nrstd = stats[2 * row2 + 1]; nx0 = *(const f32x4*)(x + o2); nx1 = *(const f32x4*)(x + o2 + 4); }
                __builtin_amdgcn_sched_barrier(0);
                const f32x4 r0 = ((x0 - mean) * rstd * g0 + b0) * DN_ALPHA + acc[ai][bj][m][0], r1 = ((x1 - mean) * rstd * g1 + b1) * DN_ALPHA + acc[ai][bj][m][1];
                *(f32x4*)(r + o) = r0; *(f32x4*)(r + o + 4) = r1; *(u32x4*)(rb + o) = pack8(r0, r1); __builtin_amdgcn_sched_barrier(0); } }
    }
};
struct EpiFinal {
    static constexpr bool PERM = true;
    float* r; const bf16_t* pe; const float* bias;
    __device__ __forceinline__ void operator()(AccRef acc, const Unit& u, int wr, int wc, int fr, int fq) const {
        const int row0 = u.pm * 256 + wr * 64 + fr, col0 = u.pn * 256 + wc * 32 + 8 * fq;
#pragma unroll
        for (int bj = 0; bj < 2; ++bj) { const int c = col0 + bj * 128;
            const f32x4 b0 = *(const f32x4*)(bias + c), b1 = *(const f32x4*)(bias + c + 4);
            u32x4 np; f32x4 nr0, nr1;
            { const size_t o = (size_t)row0 * 2048 + c; np = *(const u32x4*)(pe + o); nr0 = *(const f32x4*)(r + o); nr1 = *(const f32x4*)(r + o + 4); }
#pragma unroll
            for (int it = 0; it < 8; ++it) { const int ai = it >> 2, m = it & 3;
                const size_t o = (size_t)(row0 + ai * 128 + m * 16) * 2048 + c;
                const u32x4 pv = np; const f32x4 q0 = nr0, q1 = nr1;
                if (it + 1 < 8) { const int ai2 = (it + 1) >> 2, m2 = (it + 1) & 3; const size_t o2 = (size_t)(row0 + ai2 * 128 + m2 * 16) * 2048 + c;
                    np = *(const u32x4*)(pe + o2); nr0 = *(const f32x4*)(r + o2); nr1 = *(const f32x4*)(r + o2 + 4); }
                __builtin_amdgcn_sched_barrier(0);
                f32x4 p0, p1; unpack8(pv, p0, p1);
                f32x4 v0 = acc[ai][bj][m][0] + b0, v1 = acc[ai][bj][m][1] + b1;
#pragma unroll
                for (int j = 0; j < 4; ++j) { v0[j] = sigmoidf_(v0[j]); v1[j] = sigmoidf_(v1[j]); }
                *(f32x4*)(r + o) = q0 + v0 * p0; *(f32x4*)(r + o + 4) = q1 + v1 * p1; __builtin_amdgcn_sched_barrier(0); } }
    }
};

__device__ __forceinline__ int win_srccol(int vr) {
    if (vr < 4096) { const int pn = vr >> 8, rr = vr & 255; return rr < 128 ? pn * 128 + rr : 2048 + pn * 128 + (rr - 128); }
    if (vr < 6144) return 6144 + (vr - 4096);
    if (vr < 7168) return 8192 + (vr - 6144);
    if (vr < 8192) return 9216 + (vr - 7168);
    if (vr < 9216) return 11264 + (vr - 8192);
    if (vr < 11264) return 4096 + (vr - 9216);
    return 10240 + (vr - 11264);
}
__device__ __forceinline__ void transpose_item(const float* W, int K, int N, bf16_t* WT, int k0, int scol0, int drow0, LAS float* scr, int lane) {
#pragma unroll 8
    for (int i = 0; i < 32; ++i) { const int kk = 2 * i + (lane >> 5); scr[kk * 33 + (lane & 31)] = W[(size_t)(k0 + kk) * N + scol0 + (lane & 31)]; }
    __builtin_amdgcn_s_waitcnt(0xc07f); asm volatile("" ::: "memory");
    const int c = lane & 7;
#pragma unroll
    for (int j = 0; j < 4; ++j) { const int n = (lane >> 3) + 8 * j; const LAS float* s = scr + (8 * c) * 33 + n;
        u32x4 o; o.x = pk2(s[0 * 33], s[1 * 33]); o.y = pk2(s[2 * 33], s[3 * 33]); o.z = pk2(s[4 * 33], s[5 * 33]); o.w = pk2(s[6 * 33], s[7 * 33]);
        *(u32x4*)(WT + (size_t)(drow0 + n) * K + k0 + 8 * c) = o; }
    __builtin_amdgcn_s_waitcnt(0xc07f); asm volatile("" ::: "memory");
}
__device__ __forceinline__ void phase0(const Params& P, LAS unsigned char* lds) {
    const int tid = tid_opaque(), wave = tid >> 6, lane = tid & 63;
    const int gw = blockIdx.x * 8 + wave, NGW = gridDim.x * 8;
    bf16_t* H = (bf16_t*)(P.ws + WS_H); float* stats = (float*)(P.ws + WS_STATS);
    LAS float* scr = (LAS float*)(lds + wave * 16384);
    constexpr int I_IN = 32 * 384, I_M = 32 * 128;
    for (int it = gw; it < I_IN + I_M; it += NGW) {
        int r = it;
        if (r < I_IN) { const int kb = r / 384, nb = r % 384; transpose_item(P.w_in, 2048, 12288, (bf16_t*)(P.ws + WS_WTMAIN), 64 * kb, win_srccol(32 * nb), 32 * nb, scr, lane); continue; } r -= I_IN;
        { const int kb = r / 128, nb = r % 128; transpose_item(P.w_merge, 2048, 4096, (bf16_t*)(P.ws + WS_WMT), 64 * kb, 32 * nb, 32 * nb, scr, lane); }
    }
    for (int row = gw; row < TOK; row += NGW) {
        const f32x4* xr = (const f32x4*)(P.x + (size_t)row * DM) + lane;
        f32x4 v[8]; float s = 0.f;
#pragma unroll
        for (int j = 0; j < 8; ++j) { v[j] = xr[64 * j]; s += (v[j][0] + v[j][1]) + (v[j][2] + v[j][3]); }
        const float mean = wave_sum(s, lane) * (1.f / DM); float s2 = 0.f;
#pragma unroll
        for (int j = 0; j < 8; ++j) { v[j] = v[j] - mean; s2 += (v[j][0] * v[j][0] + v[j][1] * v[j][1]) + (v[j][2] * v[j][2] + v[j][3] * v[j][3]); }
        const float rstd = 1.f / sqrtf(wave_sum(s2, lane) * (1.f / DM) + LN_EPS);
        u32x2* o8 = (u32x2*)(H + (size_t)row * DM) + lane;
#pragma unroll
        for (int j = 0; j < 8; ++j) { const f32x4 g = *((const f32x4*)P.ln_in_g + lane + 64 * j), b = *((const f32x4*)P.ln_in_b + lane + 64 * j);
            const f32x4 y = v[j] * rstd * g + b; u32x2 w; w.x = pk2(y[0], y[1]); w.y = pk2(y[2], y[3]); o8[64 * j] = w; }
        if (lane == 0) { stats[2 * row] = mean; stats[2 * row + 1] = rstd; }
    }
}

__device__ __forceinline__ void late_transposes(const Params& P, LAS unsigned char* lds, int blk0) {
    const int tid = tid_opaque(), wave = tid >> 6, lane = tid & 63;
    const int gw = ((int)blockIdx.x - blk0) * 8 + wave, NGW = ((int)gridDim.x - blk0) * 8;
    LAS float* scr = (LAS float*)(lds + wave * 16384);
    constexpr int I_A = 32 * 64, I_B = 16 * 64, I_O = 32 * 64, I_PG = 32 * 64, I_PE = 4 * 64;
    for (int it = gw; it < I_A + I_B + I_O + I_PG + I_PE; it += NGW) {
        int r = it;
        if (r < I_A) { const int kb = r / 64, nb = r % 64; transpose_item(P.w_br_hg, 2048, 2048, (bf16_t*)(P.ws + WS_WAT), 64 * kb, 32 * nb, 32 * nb, scr, lane); continue; } r -= I_A;
        if (r < I_B) { const int kb = r / 64, nb = r % 64; transpose_item(P.w_br_sb, 1024, 2048, (bf16_t*)(P.ws + WS_WBT), 64 * kb, 32 * nb, 32 * nb, scr, lane); continue; } r -= I_B;
        if (r < I_O) { const int kb = r / 64, nb = r % 64; transpose_item(P.w_out, 2048, 2048, (bf16_t*)(P.ws + WS_WOT), 64 * kb, 32 * nb, 32 * nb, scr, lane); continue; } r -= I_O;
        if (r < I_PG) { const int kb = r / 64, nb = r % 64; transpose_item(P.w_pg, 2048, 2048, (bf16_t*)(P.ws + WS_WPGT), 64 * kb, 32 * nb, 32 * nb, scr, lane); continue; } r -= I_PG;
        { const int kb = r / 64, nb = r % 64; transpose_item(P.w_pe, 256, 2048, (bf16_t*)(P.ws + WS_WPET), 64 * kb, 32 * nb, 32 * nb, scr, lane); }
    }
    { const f32x4* ps = (const f32x4*)P.p; u32x4* pd = (u32x4*)(P.ws + WS_PB);
      for (size_t i = (size_t)((int)blockIdx.x - blk0) * 512 + tid; i < (size_t)TOK * 256 / 8; i += (size_t)((int)gridDim.x - blk0) * 512) { const f32x4 a = ps[2 * i], b = ps[2 * i + 1]; pd[i] = pack8(a, b); } }
    __syncthreads();
}

constexpr int HL_QD = 0, HL_KI = 17408, HL_KET = 34816, HL_VT = 53248, HL_ST = 71680, HL_RED = 106496, HL_HGT = 108032, HL_DEC = 125440, HL_HGT2 = 125952;
#define LDS_BARRIER() do { asm volatile("s_waitcnt lgkmcnt(0)" ::: "memory"); __builtin_amdgcn_s_barrier(); asm volatile("" ::: "memory"); } while (0)
__device__ __forceinline__ void hgrn2_seq(const Params& P, LAS unsigned char* lds, float* outbuf, int item) {
    const int tid = tid_opaque(), w = __builtin_amdgcn_readfirstlane(tid >> 6), lane = tid & 63, r = lane & 31, h = lane >> 5;
    const int tb = w >> 2, vb = w & 3, kb = w >> 1, vb2 = 2 * (w & 1);
    const int b = item >> 4, head = item & 15, hbase = head * 128; const size_t tokbase = (size_t)b * SEQ_T;
    const bf16_t* QD = (const bf16_t*)(P.ws + WS_QD); const bf16_t* KI = (const bf16_t*)outbuf; const bf16_t* KET = (const bf16_t*)outbuf + (size_t)TOK * 2048;
    const bf16_t* VT = (const bf16_t*)(P.ws + WS_VT); bf16_t* HG = (bf16_t*)(P.ws + WS_HG); const float* DEC = (const float*)(P.ws + WS_DEC);
    LAS float* RED = (LAS float*)(lds + HL_RED);
    f32x16 S[2];
#pragma unroll
    for (int q = 0; q < 2; ++q)
#pragma unroll
        for (int i = 0; i < 16; ++i) S[q][i] = 0.f;
    if (tid < 128) ((LAS float*)(lds + HL_RED + 1024))[tid] = P.hg_norm_g[hbase + tid];
    const LAS float* gnp = (const LAS float*)(lds + HL_RED + 1024) + 32 * vb + 4 * h;
    const int idA0 = tid, idA1 = tid + 512;
    const int rA0 = idA0 >> 4, cA0 = idA0 & 15, rA1 = idA1 >> 4, cA1 = idA1 & 15;
    const int rT0 = idA0 >> 3, cT0 = idA0 & 7, rT1 = idA1 >> 3, cT1 = idA1 & 7;
    u32x4 pf[10]; float pfd = 0.f;
#define HG_LOAD_PF(c) do { const size_t t0 = tokbase + 64 * (size_t)(c); \
        pf[0] = *(const u32x4*)(QD + (t0 + rA0) * 2048 + hbase + 8 * cA0); pf[1] = *(const u32x4*)(QD + (t0 + rA1) * 2048 + hbase + 8 * cA1); \
        pf[2] = *(const u32x4*)(KI + (t0 + rA0) * 2048 + hbase + 8 * cA0); pf[3] = *(const u32x4*)(KI + (t0 + rA1) * 2048 + hbase + 8 * cA1); \
        pf[4] = *(const u32x4*)(KET + ((t0 >> 6) * 2048 + hbase + rT0) * 64 + 8 * cT0); pf[5] = *(const u32x4*)(KET + ((t0 >> 6) * 2048 + hbase + rT1) * 64 + 8 * cT1); \
        pf[6] = *(const u32x4*)(VT + ((t0 >> 6) * 3072 + hbase + rT0) * 64 + 8 * cT0); pf[7] = *(const u32x4*)(VT + ((t0 >> 6) * 3072 + hbase + rT1) * 64 + 8 * cT1); \
        pf[8] = *(const u32x4*)(HG + (t0 + rA0) * 2048 + hbase + 8 * cA0); pf[9] = *(const u32x4*)(HG + (t0 + rA1) * 2048 + hbase + 8 * cA1); \
        if (tid < 128) pfd = DEC[(t0 >> 6) * 2048 + hbase + tid]; } while (0)
    HG_LOAD_PF(0);
#pragma unroll 1
    for (int c = 0; c < 256; ++c) {
        *(LAS u32x4*)(lds + HL_QD + rA0 * 272 + cA0 * 16) = pf[0]; *(LAS u32x4*)(lds + HL_QD + rA1 * 272 + cA1 * 16) = pf[1];
        *(LAS u32x4*)(lds + HL_KI + rA0 * 272 + cA0 * 16) = pf[2]; *(LAS u32x4*)(lds + HL_KI + rA1 * 272 + cA1 * 16) = pf[3];
        *(LAS u32x4*)(lds + HL_KET + rT0 * 144 + cT0 * 16) = pf[4]; *(LAS u32x4*)(lds + HL_KET + rT1 * 144 + cT1 * 16) = pf[5];
        *(LAS u32x4*)(lds + HL_VT + rT0 * 144 + cT0 * 16) = pf[6]; *(LAS u32x4*)(lds + HL_VT + rT1 * 144 + cT1 * 16) = pf[7];
        const int hgt_off = (c & 1) ? HL_HGT2 : HL_HGT;
        *(LAS u32x4*)(lds + hgt_off + rA0 * 272 + cA0 * 16) = pf[8]; *(LAS u32x4*)(lds + hgt_off + rA1 * 272 + cA1 * 16) = pf[9];
        if (tid < 128) ((LAS float*)(lds + HL_DEC))[tid] = pfd;
#pragma unroll
        for (int q = 0; q < 2; ++q)
#pragma unroll
            for (int g = 0; g < 4; ++g) { u32x2 v; v.x = pk2(S[q][4 * g], S[q][4 * g + 1]); v.y = pk2(S[q][4 * g + 2], S[q][4 * g + 3]);
                *(LAS u32x2*)(lds + HL_ST + (32 * (vb2 + q) + r) * 272 + (32 * kb + 8 * g + 4 * h) * 2) = v; }
        LDS_BARRIER();
        const size_t tok = tokbase + 64 * (size_t)c + 32 * tb + r;
        bf16_t* hgp = HG + tok * 2048 + hbase + 32 * vb + 4 * h;
        if (c + 1 < 256) HG_LOAD_PF(c + 1);
        bf16x8 qf[8];
#pragma unroll
        for (int st = 0; st < 8; ++st) qf[st] = *(const LAS bf16x8*)(lds + HL_QD + (32 * tb + r) * 272 + (16 * st + 8 * h) * 2);
        f32x16 o;
#pragma unroll
        for (int i = 0; i < 16; ++i) o[i] = 0.f;
#pragma unroll 1
        for (int sb = 0; sb <= tb; ++sb) {
            bf16x8 kf[8];
#pragma unroll
            for (int st = 0; st < 8; ++st) kf[st] = *(const LAS bf16x8*)(lds + HL_KI + (32 * sb + r) * 272 + (16 * st + 8 * h) * 2);
            u32x4 vf[2];
#pragma unroll
            for (int u = 0; u < 2; ++u) { const LAS unsigned char* vp = lds + HL_VT + (32 * vb + r) * 144 + (32 * sb + 16 * u + 4 * h) * 2;
                const u32x2 lo = *(const LAS u32x2*)vp, hi = *(const LAS u32x2*)(vp + 16); vf[u].x = lo.x; vf[u].y = lo.y; vf[u].z = hi.x; vf[u].w = hi.y; }
            __builtin_amdgcn_sched_barrier(0);
            f32x16 a0, a1;
#pragma unroll
            for (int i = 0; i < 16; ++i) { a0[i] = 0.f; a1[i] = 0.f; }
#pragma unroll
            for (int st = 0; st < 4; ++st) { a0 = MFMA32(kf[st], qf[st], a0); a1 = MFMA32(kf[st + 4], qf[st + 4], a1); }
            f32x16 a = a0 + a1;
            if (sb == tb) {
#pragma unroll
                for (int i = 0; i < 16; ++i) a[i] = (crow(i, h) <= r) ? a[i] : 0.f;
            }
#pragma unroll
            for (int u = 0; u < 2; ++u) {
                u32x4 pa; pa.x = pk2(a[8 * u], a[8 * u + 1]); pa.y = pk2(a[8 * u + 2], a[8 * u + 3]); pa.z = pk2(a[8 * u + 4], a[8 * u + 5]); pa.w = pk2(a[8 * u + 6], a[8 * u + 7]);
                o = MFMA32(__builtin_bit_cast(bf16x8, vf[u]), __builtin_bit_cast(bf16x8, pa), o);
            }
        }
        {
            bf16x8 sf[8];
#pragma unroll
            for (int st = 0; st < 8; ++st) sf[st] = *(const LAS bf16x8*)(lds + HL_ST + (32 * vb + r) * 272 + (16 * st + 8 * h) * 2);
            __builtin_amdgcn_sched_barrier(0);
            f32x16 o1;
#pragma unroll
            for (int i = 0; i < 16; ++i) o1[i] = 0.f;
#pragma unroll
            for (int st = 0; st < 4; ++st) { o = MFMA32(sf[st], qf[st], o); o1 = MFMA32(sf[st + 4], qf[st + 4], o1); }
            o = o + o1;
        }
        float ss = 0.f;
#pragma unroll
        for (int i = 0; i < 16; ++i) ss += o[i] * o[i];
        ss += lane_read(ss, lane ^ 32);
        if (h == 0) RED[vb * 64 + 32 * tb + r] = ss;
        {
            bf16x8 kef[4], vf2[2][4];
#pragma unroll
            for (int u = 0; u < 4; ++u) { kef[u] = *(const LAS bf16x8*)(lds + HL_KET + (32 * kb + r) * 144 + (16 * u + 8 * h) * 2);
#pragma unroll
                for (int q = 0; q < 2; ++q) vf2[q][u] = *(const LAS bf16x8*)(lds + HL_VT + (32 * (vb2 + q) + r) * 144 + (16 * u + 8 * h) * 2); }
#pragma unroll
            for (int g = 0; g < 4; ++g) { const f32x4 dvg = *(const LAS f32x4*)(lds + HL_DEC + (32 * kb + 8 * g + 4 * h) * 4);
#pragma unroll
                for (int q = 0; q < 2; ++q)
#pragma unroll
                    for (int e = 0; e < 4; ++e) S[q][4 * g + e] *= dvg[e]; }
            __builtin_amdgcn_sched_barrier(0);
#pragma unroll
            for (int u = 0; u < 4; ++u) { S[0] = MFMA32(kef[u], vf2[0][u], S[0]); S[1] = MFMA32(kef[u], vf2[1][u], S[1]); }
        }
        LDS_BARRIER();
        const float tot = RED[32 * tb + r] + RED[64 + 32 * tb + r] + RED[128 + 32 * tb + r] + RED[192 + 32 * tb + r];
        const float rstd = 1.f / sqrtf(tot * (1.f / 128.f) + LN_EPS);
#pragma unroll
        for (int g = 0; g < 4; ++g) {
            const u32x2 hgvg = *(const LAS u32x2*)(lds + hgt_off + (32 * tb + r) * 272 + (32 * vb + 8 * g + 4 * h) * 2);
            const float g0 = bf_lo(hgvg.x), g1 = bf_hi(hgvg.x), g2 = bf_lo(hgvg.y), g3 = bf_hi(hgvg.y);
            const f32x4 gn = *(const LAS f32x4*)(gnp + 8 * g);
            const float y0 = o[4 * g] * rstd * gn[0] * (g0 * sigmoidf_(g0)), y1 = o[4 * g + 1] * rstd * gn[1] * (g1 * sigmoidf_(g1));
            const float y2 = o[4 * g + 2] * rstd * gn[2] * (g2 * sigmoidf_(g2)), y3 = o[4 * g + 3] * rstd * gn[3] * (g3 * sigmoidf_(g3));
            u32x2 wv; wv.x = pk2(y0, y1); wv.y = pk2(y2, y3); *(u32x2*)(hgp + 8 * g) = wv;
        }
    }
#undef HG_LOAD_PF
}

__device__ __forceinline__ void sb_attention(const Params& P, int blk0) {
    const int tid_ = tid_opaque(); const int gwave = ((int)blockIdx.x - blk0) * 8 + __builtin_amdgcn_readfirstlane(tid_ >> 6), nwaves = ((int)gridDim.x - blk0) * 8;
    const int lane = tid_ & 63, r = lane & 31, h = lane >> 5;
    const bf16_t* SQ = (const bf16_t*)(P.ws + WS_SQ); const bf16_t* SK = (const bf16_t*)(P.ws + WS_SK); const bf16_t* SG = (const bf16_t*)(P.ws + WS_SG);
    const bf16_t* VT = (const bf16_t*)(P.ws + WS_VT);
    const float scale = 0.08838834764831845f;
    for (int item = gwave; item < 8192; item += nwaves) {
        const int qt = item & 511, hd = (item >> 9) & 7, b = item >> 12;
        const size_t tokbase = (size_t)b * SEQ_T;
        const bf16_t* qrow = SQ + (tokbase + 32 * qt + r) * 1024 + hd * 128 + 8 * h;
        bf16x8 qf[8];
#pragma unroll
        for (int st = 0; st < 8; ++st) qf[st] = *(const bf16x8*)(qrow + 16 * st);
        f32x16 o[4];
#pragma unroll
        for (int d = 0; d < 4; ++d)
#pragma unroll
            for (int i = 0; i < 16; ++i) o[d][i] = 0.f;
        float R = 0.f;
        bf16x8 kf[8], kfn[8]; u32x4 vf[4][2];
#define SB_LOAD_K(KF, kt_) do { \
            const bf16_t* krow_ = SK + (tokbase + 32 * (kt_) + r) * 1024 + hd * 128 + 8 * h; \
            _Pragma("unroll") for (int st = 0; st < 8; ++st) KF[st] = *(const bf16x8*)(krow_ + 16 * st); } while (0)
#define SB_LOAD_V(VF, kt_) do { \
            const bf16_t* vbase_ = VT + ((size_t)(b * 256 + ((kt_) >> 1)) * 3072 + 2048 + hd * 128 + r) * 64 + ((kt_) & 1) * 32 + 4 * h; \
            _Pragma("unroll") for (int d = 0; d < 4; ++d) _Pragma("unroll") for (int u = 0; u < 2; ++u) { const bf16_t* vp_ = vbase_ + d * 32 * 64 + 16 * u; \
                const u32x2 lo_ = *(const u32x2*)vp_, hi_ = *(const u32x2*)(vp_ + 8); VF[d][u].x = lo_.x; VF[d][u].y = lo_.y; VF[d][u].z = hi_.x; VF[d][u].w = hi_.y; } } while (0)
        SB_LOAD_K(kf, qt);
#pragma unroll 1
        for (int kt = qt; kt >= 0; --kt) {
            SB_LOAD_V(vf, kt);
            if (kt > 0) SB_LOAD_K(kfn, kt - 1);
            f32x16 s;
#pragma unroll
            for (int i = 0; i < 16; ++i) s[i] = 0.f;
#pragma unroll
            for (int st = 0; st < 8; ++st) s = MFMA32(kf[st], qf[st], s);
            const bool diag = (kt == qt);
            float l[16];
#pragma unroll
            for (int i = 0; i < 16; ++i) { const float z = s[i] * scale; s[i] = z; const float sp = fmaxf(z, 0.f) + fast_log(1.f + fast_exp(-fabsf(z)));
                const bool valid = !diag || (crow(i, h) < r); l[i] = valid ? -sp : 0.f; }
            float G[4], Hs[4], T[4];
#pragma unroll
            for (int g = 0; g < 4; ++g) { G[g] = (l[4 * g] + l[4 * g + 1]) + (l[4 * g + 2] + l[4 * g + 3]); Hs[g] = lane_read(G[g], lane ^ 32); T[g] = G[g] + Hs[g]; }
            float Bs[4]; Bs[3] = 0.f; Bs[2] = T[3]; Bs[1] = T[3] + T[2]; Bs[0] = Bs[1] + T[1];
            const float total = Bs[0] + T[0];
            float A[16];
#pragma unroll
            for (int g = 0; g < 4; ++g) {
                const float off = R + Bs[g] + (h == 0 ? Hs[g] : 0.f);
                const float c3 = off, c2 = c3 + l[4 * g + 3], c1 = c2 + l[4 * g + 2], c0 = c1 + l[4 * g + 1];
                const float cc[4] = {c0, c1, c2, c3};
#pragma unroll
                for (int e = 0; e < 4; ++e) { const int i = 4 * g + e; const bool valid = !diag || (crow(i, h) < r); const float a = fast_exp(s[i] + l[i] + cc[e]); A[i] = valid ? a : 0.f; }
            }
            R += total;
#pragma unroll
            for (int u = 0; u < 2; ++u) {
                u32x4 pa; pa.x = pk2(A[8 * u], A[8 * u + 1]); pa.y = pk2(A[8 * u + 2], A[8 * u + 3]); pa.z = pk2(A[8 * u + 4], A[8 * u + 5]); pa.w = pk2(A[8 * u + 6], A[8 * u + 7]);
#pragma unroll
                for (int d = 0; d < 4; ++d) o[d] = MFMA32(__builtin_bit_cast(bf16x8, vf[d][u]), __builtin_bit_cast(bf16x8, pa), o[d]);
            }
            if (__all(R < -104.f)) break;
#pragma unroll
            for (int st = 0; st < 8; ++st) kf[st] = kfn[st];
        }
#undef SB_LOAD_K
#undef SB_LOAD_V
        const bf16_t* sgp = SG + (tokbase + 32 * qt + r) * 1024 + hd * 128 + 4 * h; bf16_t* ybp = (bf16_t*)(P.ws + WS_YB) + (tokbase + 32 * qt + r) * 1024 + hd * 128 + 4 * h;
#pragma unroll
        for (int d = 0; d < 4; ++d)
#pragma unroll
            for (int g = 0; g < 4; ++g) { const bf16_t* pp = sgp + 32 * d + 8 * g; const u32x2 gv = *(const u32x2*)pp;
                const float g0 = bf_lo(gv.x), g1 = bf_hi(gv.x), g2 = bf_lo(gv.y), g3 = bf_hi(gv.y);
                u32x2 wv; wv.x = pk2(o[d][4 * g] * (g0 * sigmoidf_(g0)), o[d][4 * g + 1] * (g1 * sigmoidf_(g1)));
                wv.y = pk2(o[d][4 * g + 2] * (g2 * sigmoidf_(g2)), o[d][4 * g + 3] * (g3 * sigmoidf_(g3))); *(u32x2*)(ybp + 32 * d + 8 * g) = wv; }
    }
}

__device__ __forceinline__ void final_ln(const Params& P) {
    const int tid = tid_opaque(), wave = tid >> 6, lane = tid & 63;
    const int nw = gridDim.x * 8;
    for (int row = blockIdx.x * 8 + wave; row < TOK; row += 2 * nw) {
        const int row2 = row + nw;
        f32x4* xa = (f32x4*)(P.out + (size_t)row * DM) + lane; f32x4* xb = (f32x4*)(P.out + (size_t)row2 * DM) + lane;
        f32x4 va[8], vb[8]; float sa = 0.f, sb = 0.f;
#pragma unroll
        for (int j = 0; j < 8; ++j) { va[j] = xa[64 * j]; vb[j] = xb[64 * j]; }
#pragma unroll
        for (int j = 0; j < 8; ++j) { sa += (va[j][0] + va[j][1]) + (va[j][2] + va[j][3]); sb += (vb[j][0] + vb[j][1]) + (vb[j][2] + vb[j][3]); }
        const float ma = wave_sum(sa, lane) * (1.f / DM), mb = wave_sum(sb, lane) * (1.f / DM); float qa = 0.f, qb = 0.f;
#pragma unroll
        for (int j = 0; j < 8; ++j) { va[j] = va[j] - ma; vb[j] = vb[j] - mb;
            qa += (va[j][0] * va[j][0] + va[j][1] * va[j][1]) + (va[j][2] * va[j][2] + va[j][3] * va[j][3]);
            qb += (vb[j][0] * vb[j][0] + vb[j][1] * vb[j][1]) + (vb[j][2] * vb[j][2] + vb[j][3] * vb[j][3]); }
        const float ra = 1.f / sqrtf(wave_sum(qa, lane) * (1.f / DM) + LN_EPS), rb = 1.f / sqrtf(wave_sum(qb, lane) * (1.f / DM) + LN_EPS);
#pragma unroll
        for (int j = 0; j < 8; ++j) { const f32x4 g = *((const f32x4*)P.ln_g + lane + 64 * j), bb = *((const f32x4*)P.ln_b + lane + 64 * j);
            xa[64 * j] = va[j] * ra * g + bb; xb[64 * j] = vb[j] * rb * g + bb; }
    }
}

#define XB_TMO      128
#define XB_XCNT(j)  (256  + 64 * (j))
#define XB_XSUB(j)  (1280 + 64 * (j))
#define XB_XGEN(j)  (2304 + 64 * (j))
#define XB_TOP      3328
#define XB_TOPGEN   3392
#define XCD_BAR_WORDS 3456
#define XB_SPIN_CAP (1u << 18)
__device__ __forceinline__ unsigned xb_ld(unsigned* p)              { return __hip_atomic_load(p, __ATOMIC_RELAXED, __HIP_MEMORY_SCOPE_AGENT); }
__device__ __forceinline__ unsigned xb_add(unsigned* p, unsigned v) { return __hip_atomic_fetch_add(p, v, __ATOMIC_RELAXED, __HIP_MEMORY_SCOPE_AGENT); }
__device__ __forceinline__ unsigned xb_xcc_id() { return (unsigned)__builtin_amdgcn_s_getreg((3 << 11) | 20) & 0xFu; }
#define XB_SPIN(cond, bar) do { unsigned _sp = 0; while (cond) { __builtin_amdgcn_s_sleep(1); \
    if ((++_sp & 255u) == 0u) { if (xb_ld(&(bar)[XB_TMO])) break; if (_sp > XB_SPIN_CAP) { atomicAdd(&(bar)[XB_TMO], 1u); break; } } } } while (0)
__device__ __forceinline__ void xcd_barrier_complete(unsigned* bar, unsigned x, unsigned& nloc, unsigned& nx) {
    const unsigned G = gridDim.x * gridDim.y * gridDim.z;
    unsigned sum, cnt, mine, sp = 0u;
    for (;;) {
        sum = 0u; cnt = 0u; mine = 0u;
#pragma unroll
        for (unsigned j = 0; j < 16; ++j) { const unsigned c = xb_ld(&bar[XB_XCNT(j)]); sum += c; cnt += (c > 0u) ? 1u : 0u; mine = (j == x) ? c : mine; }
        if (sum == G) break;
        __builtin_amdgcn_s_sleep(1);
        if ((++sp & 255u) == 0u) { if (xb_ld(&bar[XB_TMO])) break; if (sp > XB_SPIN_CAP) { atomicAdd(&bar[XB_TMO], 1u); break; } }
    }
    nloc = mine > 0u ? mine : 1u; nx = cnt > 0u ? cnt : 1u;
}
__device__ __forceinline__ void xcd_barrier(unsigned* bar, volatile LAS unsigned* st) {
    asm volatile("s_waitcnt vmcnt(0)" ::: "memory");
    __syncthreads();
    if (tid_opaque() == 0) {
        const unsigned x = xb_xcc_id();
        __builtin_amdgcn_s_waitcnt(0);
        unsigned nloc = st[0], nx = st[1];
        if (nloc == 0u) { xcd_barrier_complete(bar, x, nloc, nx); st[0] = nloc; st[1] = nx; }
        const unsigned old = xb_add(&bar[XB_XSUB(x)], 1u);
        const unsigned gen = old / nloc;
        if (old + 1u == (gen + 1u) * nloc) {
            __builtin_amdgcn_fence(__ATOMIC_RELEASE, "agent");
            asm volatile("s_waitcnt vmcnt(0)" ::: "memory");
            const unsigned og = xb_add(&bar[XB_TOP], 1u);
            const unsigned tg = og / nx;
            if (og + 1u == (tg + 1u) * nx) xb_add(&bar[XB_TOPGEN], 1u);
            else XB_SPIN(xb_ld(&bar[XB_TOPGEN]) == tg, bar);
            __builtin_amdgcn_fence(__ATOMIC_ACQUIRE, "agent");
            xb_add(&bar[XB_XGEN(x)], 1u);
            asm volatile("s_waitcnt vmcnt(0)" ::: "memory");
        } else {
            XB_SPIN(xb_ld(&bar[XB_XGEN(x)]) == gen, bar);
            __builtin_amdgcn_fence(__ATOMIC_ACQUIRE, "agent");
            asm volatile("s_waitcnt vmcnt(0)" ::: "memory");
        }
    }
    __syncthreads();
}

__device__ __forceinline__ void subgrid_barrier(unsigned* bar, unsigned n) {
    asm volatile("s_waitcnt vmcnt(0)" ::: "memory");
    __syncthreads();
    if (tid_opaque() == 0) {
        __builtin_amdgcn_s_waitcnt(0);
        __builtin_amdgcn_fence(__ATOMIC_RELEASE, "agent");
        asm volatile("s_waitcnt vmcnt(0)" ::: "memory");
        (void)xb_add(&bar[0], 1u);
        XB_SPIN(xb_ld(&bar[0]) < n, bar);
        __builtin_amdgcn_fence(__ATOMIC_ACQUIRE, "agent");
        asm volatile("s_waitcnt vmcnt(0)" ::: "memory");
    }
    __syncthreads();
}

struct EpiU {
    static constexpr bool PERM = true;
    int mode; const Params* Pp;
    __device__ __forceinline__ void operator()(AccRef acc, const Unit& u, int wr, int wc, int fr, int fq) const {
        const Params& P = *Pp; unsigned char* ws = P.ws;
        switch (mode) {
        case 0: { EpiProj E; E.QD = (bf16_t*)(ws + WS_QD); E.KI = (bf16_t*)P.out; E.KET = (bf16_t*)P.out + (size_t)TOK * 2048; E.HG = (bf16_t*)(ws + WS_HG); E.SQ = (bf16_t*)(ws + WS_SQ);
                  E.SK = (bf16_t*)(ws + WS_SK); E.SG = (bf16_t*)(ws + WS_SG); E.DEC = (float*)(ws + WS_DEC); E.lbl = P.lb_logits; E(acc, u, wr, wc, fr, fq); } break;
        case 1: { EpiVT E; E.dst = (bf16_t*)(ws + WS_VT); E(acc, u, wr, wc, fr, fq); } break;
        case 2: { EpiGate E; E.ga = ws + WS_GA; E.gb = ws + WS_GB; E.bias = P.b_merge; E(acc, u, wr, wc, fr, fq); } break;
        case 3: { EpiMul E; E.m1 = (bf16_t*)(ws + WS_SQ); E.G = ws + WS_GB; E(acc, u, wr, wc, fr, fq); } break;
        case 4: { EpiMulAdd E; E.mo = (bf16_t*)(ws + WS_SQ); E.m1 = (const bf16_t*)(ws + WS_SQ); E.G = ws + WS_GA; E(acc, u, wr, wc, fr, fq); } break;
        case 6: { EpiOut E; E.r = P.out; E.rb = (bf16_t*)(ws + WS_QD); E.x = P.x; E.stats = (const float*)(ws + WS_STATS); E.g = P.ln_in_g; E.b = P.ln_in_b; E(acc, u, wr, wc, fr, fq); } break;
        case 7: { EpiPlain E; E.dst = (bf16_t*)(ws + WS_VT); E.ld = 2048; E(acc, u, wr, wc, fr, fq); } break;
        default: { EpiFinal E; E.r = P.out; E.pe = (const bf16_t*)(ws + WS_VT); E.bias = P.b_pg; E(acc, u, wr, wc, fr, fq); } break;
        }
    }
};
__device__ __forceinline__ void gemm_job(const Params& P, int job, LAS unsigned char* lds, int G, int c) {
    unsigned char* ws = P.ws;
    size_t a, b; int M = TOK, N = 2048, K = 2048;
    switch (job) {
    case 0: a = WS_H; b = WS_WTMAIN; N = 9216; break;
    case 1: a = WS_WTVT; b = WS_H; M = 3072; N = TOK; break;
    case 2: a = WS_H; b = WS_WMT; N = 4096; break;
    case 3: a = WS_YB; b = WS_WBT; K = 1024; break;
    case 4: a = WS_HG; b = WS_WAT; break;
    case 6: a = WS_SQ; b = WS_WOT; break;
    case 7: a = WS_PB; b = WS_WPET; K = 256; break;
    default: a = WS_QD; b = WS_WPGT; break;
    }
    pg8::Gemm g{(const bf16_t*)(ws + a), (const bf16_t*)(ws + b), M, N, K};
    pg8::StaticOrder S; S.init(M, N, G, c);
    EpiU E; E.mode = job; E.Pp = &P;
    pg8::gemm_phase(lds, g, S, E);
}
__device__ __forceinline__ void run_phase(const Params& P, int ph, LAS unsigned char* lds) {
    int j0 = 0, j1 = 0, G = (int)gridDim.x, c = (int)blockIdx.x;
    if (ph == 0) { phase0(P, lds); }
    else if (ph == 2) {
        if (c < 32) hgrn2_seq(P, lds, P.out, c);
        else { late_transposes(P, lds, 32); sb_attention(P, 32); j0 = 2; j1 = 4; G -= 32; c -= 32; }
    }
    else if (ph == 6) { final_ln(P); }
    else if (ph == 1) { j0 = 0; j1 = 2; }
    else if (ph == 3) { j0 = 4; j1 = 5; }
    else if (ph == 4) { j0 = 6; j1 = 7; }
    else { j0 = 7; j1 = 9; }
#pragma unroll 1
    for (int j = j0; j < j1; ++j) {
        if (ph == 2 && j == 3) subgrid_barrier((unsigned*)(P.ws + WS_BAR), (unsigned)G);
        gemm_job(P, j, lds, G, c);
    }
}
#ifndef MK_PROG
#define MK_PROG 0, 1, 2, 3, 4, 5, 6
#endif
__device__ __constant__ const int PROG_D[] = {MK_PROG};
static const int PROG_H[] = {MK_PROG};
constexpr int NPHASES = sizeof(PROG_H) / sizeof(int);
constexpr int LDS_BYTES = 147456 + 16;

constexpr int LDS_XB = 147456;
template <bool COOP> __global__ __launch_bounds__(512, 2) void mega(Params P) {
    extern __shared__ __attribute__((aligned(16))) unsigned char shm[];
    LAS unsigned char* lds = (LAS unsigned char*)shm;
    unsigned* bar = (unsigned*)(P.ws + WS_BAR);
    volatile LAS unsigned* st = (volatile LAS unsigned*)(lds + LDS_XB);
    if constexpr (COOP) {
        if (tid_opaque() == 0) { st[0] = 0u; st[1] = 0u; (void)xb_add(&bar[XB_XCNT(xb_xcc_id())], 1u); }
        __syncthreads();
        if (P.ph_hi < 0) cg::this_grid().sync();
    }
#pragma unroll 1
    for (int pi = P.ph_lo; pi < P.ph_hi; ++pi) {
        const int ph = PROG_D[pi];
        run_phase(P, ph, lds);
        if constexpr (COOP) { if (pi + 1 < P.ph_hi) xcd_barrier(bar, st); }
    }
}

extern "C" void kernel_launch(void* const* d_in, const int* in_sizes, int n_in, void* d_out, int out_size, void* d_ws, size_t ws_size, hipStream_t stream) {
    static int grid = 0;
    if (grid == 0) {
        if (n_in != 17 || out_size != TOK * DM || ws_size < WS_END) { fprintf(stderr, "kernel_launch: unexpected shapes (n_in %d out %d ws %zu need %zu)\n", n_in, out_size, ws_size, (size_t)WS_END); grid = -1; return; }
        int dev = 0, cus = 0, per_cu = 0;
        hipGetDevice(&dev); hipDeviceGetAttribute(&cus, hipDeviceAttributeMultiprocessorCount, dev);
        hipFuncSetAttribute((const void*)mega<true>, hipFuncAttributeMaxDynamicSharedMemorySize, LDS_BYTES);
#if MK_MULTI
        hipFuncSetAttribute((const void*)mega<false>, hipFuncAttributeMaxDynamicSharedMemorySize, LDS_BYTES);
#endif
        hipOccupancyMaxActiveBlocksPerMultiprocessor(&per_cu, (const void*)mega<true>, 512, LDS_BYTES);
        if (per_cu < 1) { fprintf(stderr, "kernel_launch: occupancy query says %d blocks/CU\n", per_cu); per_cu = 1; }
        (void)hipGetLastError();
        grid = cus;
    }
    if (grid < 0) return;
    Params P{};
    P.x = (const float*)d_in[0]; P.p = (const float*)d_in[1]; P.ln_in_g = (const float*)d_in[2]; P.ln_in_b = (const float*)d_in[3]; P.w_in = (const float*)d_in[4];
    P.lb_logits = (const float*)d_in[5]; P.hg_norm_g = (const float*)d_in[6]; P.w_merge = (const float*)d_in[7]; P.b_merge = (const float*)d_in[8];
    P.w_br_hg = (const float*)d_in[9]; P.w_br_sb = (const float*)d_in[10]; P.w_out = (const float*)d_in[11]; P.w_pe = (const float*)d_in[12];
    P.w_pg = (const float*)d_in[13]; P.b_pg = (const float*)d_in[14]; P.ln_g = (const float*)d_in[15]; P.ln_b = (const float*)d_in[16];
    P.out = (float*)d_out; P.ws = (unsigned char*)d_ws;
#if MK_MULTI
    for (int ph = 0; ph < NPHASES; ++ph) { P.ph_lo = ph; P.ph_hi = ph + 1; hipLaunchKernelGGL(mega<false>, dim3(grid), dim3(512), LDS_BYTES, stream, P); }
#else
    P.ph_lo = 0; P.ph_hi = NPHASES;
    if (hipMemsetAsync((char*)d_ws + WS_BAR, 0, XCD_BAR_WORDS * sizeof(unsigned), stream) != hipSuccess) { fprintf(stderr, "kernel_launch: memset of the barrier words failed\n"); return; }
    void* args[] = {&P};
    hipError_t e = hipLaunchCooperativeKernel((const void*)mega<true>, dim3(grid), dim3(512), args, LDS_BYTES, stream);
    if (e != hipSuccess) fprintf(stderr, "cooperative launch failed: %s (grid %d)\n", hipGetErrorString(e), grid);
#endif
}
```
